# Optimizing an MI355X kernel written in HIP

```python
import math
import jax
import jax.numpy as jnp
from jax import lax
import numpy as np

D_MODEL = 1024
BATCH = 8
SEQ = 2048
DEPTH = 1

CHUNK = 64
N_META = 16
D_MIX = 2 * D_MODEL
SB_WIDTH = D_MIX // 2
SB_HEAD_DIM = 64
SB_HEADS = SB_WIDTH // SB_HEAD_DIM
SB_QBLOCK = 128
SSD_WIDTH = D_MIX - SB_WIDTH
SSD_HEAD_DIM = 64
SSD_HEADS = SSD_WIDTH // SSD_HEAD_DIM
SSD_GROUPS = 2
SSD_HEADS_PER_GROUP = SSD_HEADS // SSD_GROUPS
SSD_STATE = 128
SSD_CONV = 4
SSD_XBC = SSD_WIDTH + 2 * SSD_GROUPS * SSD_STATE
IN_WIDTHS = (SB_WIDTH, SB_WIDTH, SB_WIDTH, SB_WIDTH, SSD_WIDTH, SSD_XBC, SSD_HEADS)
D_IN = sum(IN_WIDTHS)
EPS = 1e-5
DT_MIN = 1e-3
DT_MAX = 1e-1

kernel_name = "hybrid_stickbreak_ssd_block"


def rms_norm(x, w):
    xf = x.astype(jnp.float32)
    y = xf * lax.rsqrt(jnp.mean(xf * xf, axis=-1, keepdims=True) + EPS)
    return (y * w.astype(jnp.float32)).astype(x.dtype)


def split_cols(proj):
    outs = []
    start = 0
    for width in IN_WIDTHS:
        outs.append(proj[..., start:start + width])
        start += width
    return outs


def causal_depthwise_conv(x, w, b):
    c = x.shape[-1]
    y = lax.conv_general_dilated(
        x, w[:, None, :].astype(x.dtype), window_strides=(1,),
        padding=[(SSD_CONV - 1, 0)], dimension_numbers=("NWC", "WIO", "NWC"),
        feature_group_count=c)
    return y + b.astype(x.dtype)


def stick_breaking_attention(q, k, v):
    seqlen = q.shape[1]
    scale = 1.0 / math.sqrt(q.shape[-1])
    outs = []
    for q0 in range(0, seqlen, SB_QBLOCK):
        q1 = min(q0 + SB_QBLOCK, seqlen)
        qb = q[:, q0:q1]
        kb = k[:, :q1]
        vb = v[:, :q1]
        z = jnp.einsum("bqhd,bkhd->bhqk", qb, kb).astype(jnp.float32) * scale
        t_pos = jnp.arange(q0, q1)[:, None]
        s_pos = jnp.arange(q1)[None, :]
        strict = s_pos < t_pos
        log_keep = jnp.where(strict, jax.nn.log_sigmoid(-z), 0.0)
        after = lax.cumsum(log_keep, axis=3, reverse=True) - log_keep
        weights = jnp.where(strict, jnp.exp(jax.nn.log_sigmoid(z) + after), 0.0)
        outs.append(jnp.einsum("bhqk,bkhd->bqhd", weights.astype(v.dtype), vb))
    return jnp.concatenate(outs, axis=1)


def ssd_chunked(xs, dt, a, bmat, cmat, d_skip):
    f32 = jnp.float32
    bsz, seqlen, _ = xs.shape
    pad = (-seqlen) % CHUNK
    G, R, P, N = SSD_GROUPS, SSD_HEADS_PER_GROUP, SSD_HEAD_DIM, SSD_STATE
    x = xs.astype(f32).reshape(bsz, seqlen, SSD_HEADS, P)
    bm = bmat.astype(f32).reshape(bsz, seqlen, G, N)
    cm = cmat.astype(f32).reshape(bsz, seqlen, G, N)

    def front(t):
        return jnp.pad(t, ((0, 0), (pad, 0)) + ((0, 0),) * (t.ndim - 2))

    x, dt, bm, cm = front(x), front(dt), front(bm), front(cm)
    lp = seqlen + pad
    nc = lp // CHUNK
    x = x.reshape(bsz, nc, CHUNK, G, R, P)
    dt = dt.reshape(bsz, nc, CHUNK, G, R)
    bm = bm.reshape(bsz, nc, CHUNK, G, N)
    cm = cm.reshape(bsz, nc, CHUNK, G, N)

    xdt = x * dt[..., None]
    a_cum = jnp.cumsum(dt * a.reshape(G, R), axis=2)
    seg = a_cum[:, :, :, None] - a_cum[:, :, None]
    causal = jnp.tril(jnp.ones((CHUNK, CHUNK), bool))[:, :, None, None]
    decay_ls = jnp.exp(jnp.where(causal, seg, -jnp.inf))
    cb = jnp.einsum("bclgn,bcsgn->bclsg", cm, bm)
    y_diag = jnp.einsum("bclsg,bclsgr,bcsgrp->bclgrp", cb, decay_ls, xdt)
    decay_to_end = jnp.exp(a_cum[:, :, -1:] - a_cum)
    states = jnp.einsum("bclgn,bclgr,bclgrp->bcgrpn", bm, decay_to_end, xdt)
    chunk_decay = jnp.exp(a_cum[:, :, -1])

    def step(h, inp):
        st, dec = inp
        return h * dec[..., None, None] + st, h

    h0 = jnp.zeros((bsz, G, R, P, N), f32)
    _, h_start = lax.scan(step, h0, (jnp.moveaxis(states, 1, 0), jnp.moveaxis(chunk_decay, 1, 0)))
    h_start = jnp.moveaxis(h_start, 0, 1)
    y_off = jnp.einsum("bclgn,bcgrpn,bclgr->bclgrp", cm, h_start, jnp.exp(a_cum))
    y = y_diag + y_off + x * d_skip.astype(f32).reshape(G, R)[:, :, None]
    y = y.reshape(bsz, lp, SSD_WIDTH)[:, pad:]
    return y.astype(xs.dtype)


def hybrid_layer(h, norm_w, w_in, conv_w, conv_b, dt_bias, a_log, d_skip, sb_norm_w, ssd_norm_w, w_out):
    bsz, seqlen, _ = h.shape
    u = rms_norm(h, norm_w)
    proj = jnp.einsum("bld,de->ble", u, w_in)
    q, k, v, sb_gate, ssd_z, xbc, dt_raw = split_cols(proj)
    hs = (bsz, seqlen, SB_HEADS, SB_HEAD_DIM)
    o_sb = stick_breaking_attention(q.reshape(hs), k.reshape(hs), v.reshape(hs))
    o_sb = o_sb.reshape(bsz, seqlen, SB_WIDTH)
    y_sb = rms_norm(o_sb * jax.nn.silu(sb_gate), sb_norm_w)
    xbc = jax.nn.silu(causal_depthwise_conv(xbc, conv_w, conv_b))
    xs = xbc[..., :SSD_WIDTH]
    bmat = xbc[..., SSD_WIDTH:SSD_WIDTH + SSD_GROUPS * SSD_STATE]
    cmat = xbc[..., SSD_WIDTH + SSD_GROUPS * SSD_STATE:]
    dt = jax.nn.softplus(dt_raw.astype(jnp.float32) + dt_bias.astype(jnp.float32))
    a = -jnp.exp(a_log.astype(jnp.float32))
    o_ssd = ssd_chunked(xs, dt, a, bmat, cmat, d_skip)
    y_ssd = rms_norm(o_ssd * jax.nn.silu(ssd_z), ssd_norm_w)
    y = jnp.concatenate([y_sb, y_ssd], axis=-1)
    return h + jnp.einsum("ble,ed->bld", y, w_out)


def setup_inputs(seed: int = 0) -> dict:
    key = jax.random.key(seed)
    ks = jax.random.split(key, 13)
    nrm = jax.random.normal
    x = nrm(ks[0], (BATCH, SEQ, D_MODEL), jnp.float32)
    meta_tokens = nrm(ks[1], (N_META, D_MODEL), jnp.float32)
    norm_w = 1.0 + 0.02 * nrm(ks[2], (DEPTH, D_MODEL), jnp.float32)
    w_in = nrm(ks[3], (DEPTH, D_MODEL, D_IN), jnp.float32) * D_MODEL ** -0.5
    conv_w = nrm(ks[4], (DEPTH, SSD_CONV, SSD_XBC), jnp.float32) * SSD_CONV ** -0.5
    conv_b = 0.02 * nrm(ks[5], (DEPTH, SSD_XBC), jnp.float32)
    dt0 = jnp.exp(jax.random.uniform(ks[6], (DEPTH, SSD_HEADS), jnp.float32,
                                     minval=math.log(DT_MIN), maxval=math.log(DT_MAX)))
    dt_bias = dt0 + jnp.log(-jnp.expm1(-dt0))
    a_log = jnp.log(jax.random.uniform(ks[7], (DEPTH, SSD_HEADS), jnp.float32, minval=1.0, maxval=16.0))
    d_skip = 1.0 + 0.1 * nrm(ks[8], (DEPTH, SSD_HEADS), jnp.float32)
    sb_norm_w = 1.0 + 0.02 * nrm(ks[9], (DEPTH, SB_WIDTH), jnp.float32)
    ssd_norm_w = 1.0 + 0.02 * nrm(ks[10], (DEPTH, SSD_WIDTH), jnp.float32)
    w_out = nrm(ks[11], (DEPTH, D_MIX, D_MODEL), jnp.float32) * D_MIX ** -0.5
    final_norm_w = 1.0 + 0.02 * nrm(ks[12], (D_MODEL,), jnp.float32)
    return {"x": x, "meta_tokens": meta_tokens, "norm_w": norm_w, "w_in": w_in,
            "conv_w": conv_w, "conv_b": conv_b, "dt_bias": dt_bias, "a_log": a_log,
            "d_skip": d_skip, "sb_norm_w": sb_norm_w, "ssd_norm_w": ssd_norm_w,
            "w_out": w_out, "final_norm_w": final_norm_w}


def reference(x, meta_tokens, norm_w, w_in, conv_w, conv_b, dt_bias, a_log, d_skip,
              sb_norm_w, ssd_norm_w, w_out, final_norm_w):
    bsz = x.shape[0]
    meta = jnp.broadcast_to(meta_tokens.astype(x.dtype)[None], (bsz, N_META, D_MODEL))
    h = jnp.concatenate([meta, x], axis=1)
    for layer in range(DEPTH):
        h = hybrid_layer(h, norm_w[layer], w_in[layer], conv_w[layer], conv_b[layer],
                         dt_bias[layer], a_log[layer], d_skip[layer], sb_norm_w[layer],
                         ssd_norm_w[layer], w_out[layer])
    h = rms_norm(h, final_norm_w)
    return h[:, N_META:]
```

```cpp
#include <hip/hip_runtime.h>
#include <hip/hip_cooperative_groups.h>
#include <cstdio>
#include <cstdint>
namespace cg = cooperative_groups;

typedef unsigned short bf16_t;
typedef unsigned u32x4 __attribute__((ext_vector_type(4)));
typedef unsigned u32x2 __attribute__((ext_vector_type(2)));
typedef float f32x4 __attribute__((ext_vector_type(4)));

constexpr int DM = 1024, NB = 8, SEQ = 2048, NMETA = 16, LT = SEQ + NMETA  ;
constexpr int MX = NB * SEQ;
constexpr int MA = 16640;
constexpr int DIN = 6672, NPAD = 6912;
constexpr int XBCW = 1536;
constexpr float EPS = 1e-5f;
constexpr int NTHREADS = 512;

constexpr size_t MiB = 1u << 20;
constexpr size_t WS_CTL = 0;
constexpr size_t WS_WTIN = 1 * MiB;
constexpr size_t WS_WTOUT = 15 * MiB;
constexpr size_t WS_DT = 19 * MiB;
constexpr size_t WS_SSQ = 21 * MiB;
constexpr size_t WS_XN = 24 * MiB;
constexpr size_t WS_KB = 57 * MiB;
constexpr size_t WS_VT = 90 * MiB;
constexpr size_t WS_GZ = 123 * MiB;
constexpr size_t WS_XBC = 187 * MiB;
constexpr size_t WS_END = 236 * MiB;

constexpr int LDS_BYTES = 147456;

struct Params {
    const float *x, *meta, *norm_w, *w_in, *conv_w, *conv_b, *dt_bias, *a_log, *d_skip, *sb_norm_w, *ssd_norm_w, *w_out, *final_w;
    float* out; unsigned char* ws; int ph_lo, ph_hi;
};

__device__ __forceinline__ float bf2f(unsigned v) { return __uint_as_float(v << 16); }
__device__ __forceinline__ unsigned f2bf(float f) { unsigned u = __float_as_uint(f); return (u + 0x7fffu + ((u >> 16) & 1u)) >> 16; }
__device__ __forceinline__ unsigned pk2(float lo, float hi) { return f2bf(lo) | (f2bf(hi) << 16); }
__device__ __forceinline__ float wave_sum(float v) {
#pragma unroll
    for (int o = 1; o < 64; o <<= 1) v += __shfl_xor(v, o);
    return v;
}
__device__ __forceinline__ float silu_f(float v) { return v / (1.0f + __expf(-v)); }
__device__ __forceinline__ float softplus_f(float v) { return v > 20.0f ? v : log1pf(__expf(v)); }
__device__ __forceinline__ void unpack8(const u32x4 w, float* f) {
    f[0] = bf2f(w.x & 0xffffu); f[1] = bf2f(w.x >> 16); f[2] = bf2f(w.y & 0xffffu); f[3] = bf2f(w.y >> 16);
    f[4] = bf2f(w.z & 0xffffu); f[5] = bf2f(w.z >> 16); f[6] = bf2f(w.w & 0xffffu); f[7] = bf2f(w.w >> 16);
}

__device__ __forceinline__ void phase0(const Params& P, int vb, int nb) {
    const int tid = threadIdx.x, lane = tid & 63, wave = tid >> 6;
    bf16_t* XN = (bf16_t*)(P.ws + WS_XN);
    bf16_t* WTIN = (bf16_t*)(P.ws + WS_WTIN);
    bf16_t* WTOUT = (bf16_t*)(P.ws + WS_WTOUT);
    for (int m = vb * 8 + wave; m < MA; m += nb * 8) {
        u32x2* o8 = (u32x2*)(XN + (size_t)m * DM) + lane;
        if (m >= MX + NMETA) {
#pragma unroll
            for (int j = 0; j < 4; ++j) o8[64 * j] = (u32x2){0u, 0u};
        } else {
            const float* src = (m < MX) ? P.x + (size_t)m * DM : P.meta + (size_t)(m - MX) * DM;
            const f32x4* xr = (const f32x4*)src + lane;
            f32x4 v[4]; float ss = 0.f;
#pragma unroll
            for (int j = 0; j < 4; ++j) { v[j] = xr[64 * j]; ss += (v[j].x * v[j].x + v[j].y * v[j].y) + (v[j].z * v[j].z + v[j].w * v[j].w); }
            const float rstd = 1.0f / sqrtf(wave_sum(ss) * (1.0f / DM) + EPS);
#pragma unroll
            for (int j = 0; j < 4; ++j) o8[64 * j] = (u32x2){pk2(v[j].x * rstd, v[j].y * rstd), pk2(v[j].z * rstd, v[j].w * rstd)};
        }
    }
    const int gt = vb * NTHREADS + tid, ngt = nb * NTHREADS;
    for (int id = gt; id < NPAD * (DM / 8); id += ngt) {
        const int n = id % NPAD, kc = id / NPAD;
        u32x4 w = (u32x4){0u, 0u, 0u, 0u};
        if (n < DIN) {
            float f[8];
#pragma unroll
            for (int j = 0; j < 8; ++j) f[j] = P.w_in[(size_t)(8 * kc + j) * DIN + n] * P.norm_w[8 * kc + j];
            w = (u32x4){pk2(f[0], f[1]), pk2(f[2], f[3]), pk2(f[4], f[5]), pk2(f[6], f[7])};
        }
        *(u32x4*)(WTIN + (size_t)n * DM + 8 * kc) = w;
    }
    for (int id = gt; id < DM * (2048 / 8); id += ngt) {
        const int n = id % DM, kc = id / DM;
        float f[8];
#pragma unroll
        for (int j = 0; j < 8; ++j) { const int k = 8 * kc + j; const float s = (k < 1024) ? P.sb_norm_w[k] : P.ssd_norm_w[k - 1024]; f[j] = P.w_out[(size_t)k * DM + n] * s; }
        *(u32x4*)(WTOUT + (size_t)n * 2048 + 8 * kc) = (u32x4){pk2(f[0], f[1]), pk2(f[2], f[3]), pk2(f[4], f[5]), pk2(f[6], f[7])};
    }
}

template <class Epi>
__device__ __forceinline__ void simple_gemm(const bf16_t* A, const bf16_t* Bt, int M, int N, int K, const Epi& E, float* lds, int vb, int nb) {
    constexpr int LDP = 132;
    float* As = lds; float* Bs = lds + 32 * LDP;
    const int tid = threadIdx.x, tx = tid & 31, ty = tid >> 5;
    const int lrow = tid >> 2, lkc = tid & 3;
    const int nTn = N / 128, ntiles = (M / 128) * nTn;
    for (int tile = vb; tile < ntiles; tile += nb) {
        const int m0 = (tile / nTn) * 128, n0 = (tile % nTn) * 128;
        float acc[8][4];
#pragma unroll
        for (int i = 0; i < 8; ++i)
#pragma unroll
            for (int j = 0; j < 4; ++j) acc[i][j] = 0.f;
        E.begin(m0 + ty * 8);
        for (int k0 = 0; k0 < K; k0 += 32) {
            if (k0 == K / 2) E.mid(acc, m0 + ty * 8);
            __syncthreads();
            { const u32x4 wa = *(const u32x4*)(A + (size_t)(m0 + lrow) * K + k0 + 8 * lkc); float f[8]; unpack8(wa, f);
#pragma unroll
              for (int j = 0; j < 8; ++j) As[(8 * lkc + j) * LDP + lrow] = f[j];
              const u32x4 wb = *(const u32x4*)(Bt + (size_t)(n0 + lrow) * K + k0 + 8 * lkc); unpack8(wb, f);
#pragma unroll
              for (int j = 0; j < 8; ++j) Bs[(8 * lkc + j) * LDP + lrow] = f[j]; }
            __syncthreads();
#pragma unroll 8
            for (int k = 0; k < 32; ++k) {
                const f32x4 a0 = *(const f32x4*)(As + k * LDP + ty * 8), a1 = *(const f32x4*)(As + k * LDP + ty * 8 + 4), b = *(const f32x4*)(Bs + k * LDP + tx * 4);
                const float av[8] = {a0.x, a0.y, a0.z, a0.w, a1.x, a1.y, a1.z, a1.w};
#pragma unroll
                for (int i = 0; i < 8; ++i) { acc[i][0] += av[i] * b.x; acc[i][1] += av[i] * b.y; acc[i][2] += av[i] * b.z; acc[i][3] += av[i] * b.w; }
            }
        }
#pragma unroll
        for (int i = 0; i < 8; ++i) E.store(m0 + ty * 8 + i, n0 + tx * 4, acc[i], i);
    }
}

struct Epi1 {
    bf16_t *Q, *KB, *VT, *GZ, *XBC; float* DT; const float* dt_bias;
    __device__ __forceinline__ void begin(int) const {}
    __device__ __forceinline__ void mid(float (&)[8][4], int) const {}
    __device__ __forceinline__ void store(int m, int n, const float (&v)[4], int) const {
        if (m >= MX + NMETA || n >= DIN) return;
        const bool meta = m >= MX;
        const int b0 = meta ? 0 : (m >> 11), b1 = meta ? NB : b0 + 1, t = meta ? (m - MX) : (NMETA + (m & 2047));
        if (n < 1024) { if (!meta) *(u32x2*)(Q + (size_t)m * 1024 + n) = (u32x2){pk2(v[0] * 0.125f, v[1] * 0.125f), pk2(v[2] * 0.125f, v[3] * 0.125f)}; }
        else if (n < 2048) { for (int b = b0; b < b1; ++b) *(u32x2*)(KB + ((size_t)b * LT + t) * 1024 + (n - 1024)) = (u32x2){pk2(v[0], v[1]), pk2(v[2], v[3])}; }
        else if (n < 3072) { for (int b = b0; b < b1; ++b)
#pragma unroll
                for (int j = 0; j < 4; ++j) VT[((size_t)b * 1024 + (n - 2048 + j)) * LT + t] = (bf16_t)f2bf(v[j]); }
        else if (n < 5120) { if (!meta) *(u32x2*)(GZ + (size_t)m * 2048 + (n - 3072)) = (u32x2){pk2(silu_f(v[0]), silu_f(v[1])), pk2(silu_f(v[2]), silu_f(v[3]))}; }
        else if (n < 6656) { for (int b = b0; b < b1; ++b) *(u32x2*)(XBC + ((size_t)b * LT + t) * XBCW + (n - 5120)) = (u32x2){pk2(v[0], v[1]), pk2(v[2], v[3])}; }
        else { for (int b = b0; b < b1; ++b)
#pragma unroll
                for (int j = 0; j < 4; ++j) DT[((size_t)b * LT + t) * 16 + (n - 6656 + j)] = softplus_f(v[j] + dt_bias[n - 6656 + j]); }
    }
};

__device__ __forceinline__ void row_rstd(const float* SSQ, int m, float& rs_sb, float& rs_ssd) {
    const f32x4* p = (const f32x4*)(SSQ + (size_t)m * 32);
    float s1 = 0.f, s2 = 0.f;
#pragma unroll
    for (int j = 0; j < 4; ++j) { const f32x4 a = p[j], b = p[4 + j]; s1 += (a.x + a.y) + (a.z + a.w); s2 += (b.x + b.y) + (b.z + b.w); }
    rs_sb = 1.0f / sqrtf(s1 * (1.0f / 1024.0f) + EPS); rs_ssd = 1.0f / sqrtf(s2 * (1.0f / 1024.0f) + EPS);
}

struct Epi2 {
    const float* SSQ; const float* x; float* out;
    mutable float rs2[8];
    __device__ __forceinline__ void begin(int) const {}
    __device__ __forceinline__ void mid(float (&acc)[8][4], int mrow0) const {
#pragma unroll
        for (int i = 0; i < 8; ++i) { float a, b; row_rstd(SSQ, mrow0 + i, a, b); rs2[i] = b; const float r = a / b;
#pragma unroll
            for (int j = 0; j < 4; ++j) acc[i][j] *= r; }
    }
    __device__ __forceinline__ void store(int m, int n, const float (&v)[4], int i) const {
        const f32x4 xv = *(const f32x4*)(x + (size_t)m * DM + n);
        *(f32x4*)(out + (size_t)m * DM + n) = (f32x4){xv.x + v[0] * rs2[i], xv.y + v[1] * rs2[i], xv.z + v[2] * rs2[i], xv.w + v[3] * rs2[i]};
    }
};

__device__ __forceinline__ void attn_simple(const Params& P, float* lds, int vb, int nb) {
    const bf16_t* Q = (const bf16_t*)P.out;
    const bf16_t* KB = (const bf16_t*)(P.ws + WS_KB);
    const bf16_t* VT = (const bf16_t*)(P.ws + WS_VT);
    bf16_t* GZ = (bf16_t*)(P.ws + WS_GZ);
    float* SSQ = (float*)(P.ws + WS_SSQ);
    float* Ks = lds; float* Vs = lds + 64 * 64;
    const int tid = threadIdx.x;
    for (int unit = vb; unit < NB * 16 * 4; unit += nb) {
        const int qb = 3 - (unit & 3), h = (unit >> 2) & 15, b = unit >> 6;
        const int i = qb * 512 + tid, t = NMETA + i, m = b * SEQ + i;
        float q[64], o[64];
#pragma unroll
        for (int c = 0; c < 8; ++c) { const u32x4 w = *(const u32x4*)(Q + (size_t)m * 1024 + h * 64 + 8 * c); unpack8(w, q + 8 * c); }
#pragma unroll
        for (int d = 0; d < 64; ++d) o[d] = 0.f;
        float carry = 0.f;
        const int t_hi = NMETA + qb * 512 + 511;
        for (int kt = (t_hi - 1) >> 6; kt >= 0; --kt) {
            __syncthreads();
            { const int key = tid >> 3, dc = tid & 7, s = 64 * kt + key;
              u32x4 w = (u32x4){0u, 0u, 0u, 0u};
              if (s < LT) w = *(const u32x4*)(KB + ((size_t)b * LT + s) * 1024 + h * 64 + 8 * dc);
              float f[8]; unpack8(w, f);
#pragma unroll
              for (int j = 0; j < 8; ++j) Ks[key * 64 + 8 * dc + j] = f[j];
              const int d = tid >> 3, sc = tid & 7, s8 = 64 * kt + 8 * sc;
              w = (u32x4){0u, 0u, 0u, 0u};
              if (s8 < LT) w = *(const u32x4*)(VT + ((size_t)b * 1024 + h * 64 + d) * LT + s8);
              unpack8(w, f);
#pragma unroll
              for (int j = 0; j < 8; ++j) Vs[(8 * sc + j) * 64 + d] = f[j]; }
            __syncthreads();
            for (int sl = 63; sl >= 0; --sl) {
                const int s = 64 * kt + sl;
                if (s < t) {
                    float z = 0.f;
#pragma unroll
                    for (int d = 0; d < 64; d += 4) { const f32x4 kv = *(const f32x4*)(Ks + sl * 64 + d); z += q[d] * kv.x + q[d + 1] * kv.y + q[d + 2] * kv.z + q[d + 3] * kv.w; }
                    const float ls = -softplus_f(z);
                    const float w = __expf(z + ls + carry);
                    carry += ls;
#pragma unroll
                    for (int d = 0; d < 64; d += 4) { const f32x4 vv = *(const f32x4*)(Vs + sl * 64 + d); o[d] += w * vv.x; o[d + 1] += w * vv.y; o[d + 2] += w * vv.z; o[d + 3] += w * vv.w; }
                }
            }
        }
        float ss = 0.f;
#pragma unroll
        for (int c = 0; c < 8; ++c) {
            u32x4* gp = (u32x4*)(GZ + (size_t)m * 2048 + h * 64 + 8 * c);
            float g[8]; unpack8(*gp, g);
#pragma unroll
            for (int j = 0; j < 8; ++j) { g[j] *= o[8 * c + j]; ss += g[j] * g[j]; }
            *gp = (u32x4){pk2(g[0], g[1]), pk2(g[2], g[3]), pk2(g[4], g[5]), pk2(g[6], g[7])};
        }
        SSQ[(size_t)m * 32 + h] = ss;
    }
}

__device__ __forceinline__ void ssd_simple(const Params& P, float* lds, int vb, int nb) {
    const bf16_t* XBC = (const bf16_t*)(P.ws + WS_XBC);
    const float* DT = (const float*)(P.ws + WS_DT);
    bf16_t* GZ = (bf16_t*)(P.ws + WS_GZ);
    float* SSQ = (float*)(P.ws + WS_SSQ);
    float* xs_l = lds; float* B_l = lds + 16 * 512; float* C_l = B_l + 16 * 128; float* dt_l = C_l + 16 * 128;
    const int tid = threadIdx.x, lane = tid & 63, r = tid >> 6;
    for (int unit = vb; unit < NB * 2; unit += nb) {
        const int b = unit >> 1, g = unit & 1, hh = g * 8 + r;
        const float a = -__expf(P.a_log[hh]), Dk = P.d_skip[hh];
        float hs[128];
#pragma unroll
        for (int n = 0; n < 128; ++n) hs[n] = 0.f;
        for (int t0 = 0; t0 < LT; t0 += 16) {
            __syncthreads();
            for (int id = tid; id < 16 * 768; id += NTHREADS) {
                const int tt = id / 768, cc = id % 768, t = t0 + tt;
                int c; float* dst;
                if (cc < 512) { c = g * 512 + cc; dst = xs_l + tt * 512 + cc; }
                else if (cc < 640) { c = 1024 + g * 128 + (cc - 512); dst = B_l + tt * 128 + (cc - 512); }
                else { c = 1280 + g * 128 + (cc - 640); dst = C_l + tt * 128 + (cc - 640); }
                float v = P.conv_b[c];
#pragma unroll
                for (int j = 0; j < 4; ++j) { const int ts = t - 3 + j; if (ts >= 0) v += P.conv_w[j * XBCW + c] * bf2f(XBC[((size_t)b * LT + ts) * XBCW + c]); }
                *dst = silu_f(v);
            }
            if (tid < 128) dt_l[tid] = DT[((size_t)b * LT + t0 + (tid >> 3)) * 16 + g * 8 + (tid & 7)];
            __syncthreads();
#pragma unroll 1
            for (int tt = 0; tt < 16; ++tt) {
                const float dtv = dt_l[tt * 8 + r], dA = __expf(dtv * a), xv = xs_l[tt * 512 + r * 64 + lane], dtx = dtv * xv;
                float y = 0.f;
#pragma unroll
                for (int n = 0; n < 128; n += 4) {
                    const f32x4 bv = *(const f32x4*)(B_l + tt * 128 + n), cv = *(const f32x4*)(C_l + tt * 128 + n);
                    hs[n] = hs[n] * dA + dtx * bv.x; y += cv.x * hs[n];
                    hs[n + 1] = hs[n + 1] * dA + dtx * bv.y; y += cv.y * hs[n + 1];
                    hs[n + 2] = hs[n + 2] * dA + dtx * bv.z; y += cv.z * hs[n + 2];
                    hs[n + 3] = hs[n + 3] * dA + dtx * bv.w; y += cv.w * hs[n + 3];
                }
                y += Dk * xv;
                const int t = t0 + tt;
                if (t >= NMETA) {
                    const size_t m = (size_t)b * SEQ + (t - NMETA);
                    bf16_t* gp = GZ + m * 2048 + 1024 + hh * 64 + lane;
                    const float gv = y * bf2f(*gp);
                    *gp = (bf16_t)f2bf(gv);
                    const float ss = wave_sum(gv * gv);
                    if (lane == 0) SSQ[m * 32 + 16 + hh] = ss;
                }
            }
        }
    }
}

__device__ __forceinline__ void final_norm(const Params& P, int vb, int nb) {
    const int tid = threadIdx.x, lane = tid & 63, wave = tid >> 6;
    for (int m = vb * 8 + wave; m < MX; m += nb * 8) {
        f32x4* xr = (f32x4*)(P.out + (size_t)m * DM) + lane;
        const f32x4* wr = (const f32x4*)P.final_w + lane;
        f32x4 v[4]; float ss = 0.f;
#pragma unroll
        for (int j = 0; j < 4; ++j) { v[j] = xr[64 * j]; ss += (v[j].x * v[j].x + v[j].y * v[j].y) + (v[j].z * v[j].z + v[j].w * v[j].w); }
        const float rstd = 1.0f / sqrtf(wave_sum(ss) * (1.0f / DM) + EPS);
#pragma unroll
        for (int j = 0; j < 4; ++j) { const f32x4 w = wr[64 * j]; xr[64 * j] = (f32x4){v[j].x * rstd * w.x, v[j].y * rstd * w.y, v[j].z * rstd * w.z, v[j].w * rstd * w.w}; }
    }
}

__global__ void __launch_bounds__(NTHREADS) hybrid_fwd(Params P) {
    extern __shared__ __attribute__((aligned(16))) unsigned char lds_raw[];
    float* lds = (float*)lds_raw;
    cg::grid_group grid = cg::this_grid();
    const int vb = blockIdx.x, nb = gridDim.x;
    const int lo = P.ph_lo, hi = P.ph_hi;
#define IN(k) (lo <= (k) && (k) < hi)
#define BOTH(k) (IN(k) && IN((k) + 1))
    if (IN(0)) { phase0(P, vb, nb); if (BOTH(0)) grid.sync(); }
    if (IN(1)) {
        Epi1 E{(bf16_t*)P.out, (bf16_t*)(P.ws + WS_KB), (bf16_t*)(P.ws + WS_VT), (bf16_t*)(P.ws + WS_GZ), (bf16_t*)(P.ws + WS_XBC), (float*)(P.ws + WS_DT), P.dt_bias};
        simple_gemm(( const bf16_t*)(P.ws + WS_XN), (const bf16_t*)(P.ws + WS_WTIN), MA, NPAD, DM, E, lds, vb, nb);
        if (BOTH(1)) grid.sync();
    }
    if (IN(2)) {
        if (vb < NB * 2) ssd_simple(P, lds, vb, nb);
        else attn_simple(P, lds, vb - NB * 2, nb - NB * 2);
        if (BOTH(2)) grid.sync();
    }
    if (IN(3)) {
        Epi2 E{(const float*)(P.ws + WS_SSQ), P.x, P.out, {}};
        simple_gemm((const bf16_t*)(P.ws + WS_GZ), (const bf16_t*)(P.ws + WS_WTOUT), MX, DM, 2048, E, lds, vb, nb);
        if (BOTH(3)) grid.sync();
    }
    if (IN(4)) final_norm(P, vb, nb);
#undef IN
#undef BOTH
}

#ifndef MK_N_LAUNCHES
#define MK_N_LAUNCHES 1
#endif

extern "C" void kernel_launch(void* const* d_in, const int* in_sizes, int n_in, void* d_out, int out_size, void* d_ws, size_t ws_size, hipStream_t stream) {
    static int grid = 0;
    if (grid == 0) {
        if (n_in != 13 || out_size != MX * DM || ws_size < WS_END) { fprintf(stderr, "kernel_launch: unexpected sizes (n_in %d out %d ws %zu)\n", n_in, out_size, ws_size); grid = -1; return; }
        int dev = 0, cus = 0, per_cu = 0;
        (void)hipGetDevice(&dev);
        (void)hipDeviceGetAttribute(&cus, hipDeviceAttributeMultiprocessorCount, dev);
        (void)hipFuncSetAttribute((const void*)hybrid_fwd, hipFuncAttributeMaxDynamicSharedMemorySize, LDS_BYTES);
        (void)hipOccupancyMaxActiveBlocksPerMultiprocessor(&per_cu, (const void*)hybrid_fwd, NTHREADS, LDS_BYTES);
        if (per_cu < 1) { fprintf(stderr, "kernel_launch: occupancy query says %d blocks per CU\n", per_cu); grid = -1; return; }
        grid = cus;
    }
    if (grid < 0) return;
    Params p{};
    p.x = (const float*)d_in[0]; p.meta = (const float*)d_in[1]; p.norm_w = (const float*)d_in[2]; p.w_in = (const float*)d_in[3];
    p.conv_w = (const float*)d_in[4]; p.conv_b = (const float*)d_in[5]; p.dt_bias = (const float*)d_in[6]; p.a_log = (const float*)d_in[7];
    p.d_skip = (const float*)d_in[8]; p.sb_norm_w = (const float*)d_in[9]; p.ssd_norm_w = (const float*)d_in[10]; p.w_out = (const float*)d_in[11];
    p.final_w = (const float*)d_in[12]; p.out = (float*)d_out; p.ws = (unsigned char*)d_ws;
#if MK_N_LAUNCHES == 1
    p.ph_lo = 0; p.ph_hi = 5;
    void* args[] = {&p};
    hipError_t e = hipLaunchCooperativeKernel((const void*)hybrid_fwd, dim3(grid), dim3(NTHREADS), args, LDS_BYTES, stream);
    if (e != hipSuccess) fprintf(stderr, "cooperative launch failed: %s (grid %d)\n", hipGetErrorString(e), grid);
#else
    for (int ph = 0; ph < 5; ++ph) { p.ph_lo = ph; p.ph_hi = ph + 1; hipLaunchKernelGGL(hybrid_fwd, dim3(grid), dim3(NTHREADS), LDS_BYTES, stream, p); }
#endif
}
```

```cpp
#include <hip/hip_runtime.h>
#include <hip/hip_cooperative_groups.h>
#include <cstdio>
#include <cstdint>
namespace cg = cooperative_groups;

typedef unsigned short bf16_t;
typedef unsigned u32x4 __attribute__((ext_vector_type(4)));
typedef unsigned u32x2 __attribute__((ext_vector_type(2)));
typedef float f32x4 __attribute__((ext_vector_type(4)));

constexpr int DM = 1024, NB = 8, SEQ = 2048, NMETA = 16, LT = SEQ + NMETA  ;
constexpr int MX = NB * SEQ;
constexpr int MA = 16640;
constexpr int DIN = 6672, NPAD = 6912;
constexpr int XBCW = 1536;
constexpr float EPS = 1e-5f;
constexpr int NTHREADS = 512;

constexpr size_t MiB = 1u << 20;
constexpr size_t WS_CTL = 0;
constexpr size_t WS_WTIN = 1 * MiB;
constexpr size_t WS_WTOUT = 15 * MiB;
constexpr size_t WS_DT = 19 * MiB;
constexpr size_t WS_SSQ = 21 * MiB;
constexpr size_t WS_XN = 24 * MiB;
constexpr size_t WS_KB = 57 * MiB;
constexpr size_t WS_VT = 90 * MiB;
constexpr size_t WS_GZ = 123 * MiB;
constexpr size_t WS_XBC = 187 * MiB;
constexpr size_t WS_END = 236 * MiB;

constexpr int LDS_BYTES = 147456;

struct Params {
    const float *x, *meta, *norm_w, *w_in, *conv_w, *conv_b, *dt_bias, *a_log, *d_skip, *sb_norm_w, *ssd_norm_w, *w_out, *final_w;
    float* out; unsigned char* ws; int ph_lo, ph_hi;
};

__device__ __forceinline__ float bf2f(unsigned v) { return __uint_as_float(v << 16); }
__device__ __forceinline__ unsigned f2bf(float f) { unsigned u = __float_as_uint(f); return (u + 0x7fffu + ((u >> 16) & 1u)) >> 16; }
__device__ __forceinline__ unsigned pk2(float lo, float hi) { return f2bf(lo) | (f2bf(hi) << 16); }
__device__ __forceinline__ float wave_sum(float v) {
#pragma unroll
    for (int o = 1; o < 64; o <<= 1) v += __shfl_xor(v, o);
    return v;
}
__device__ __forceinline__ float silu_f(float v) { return v / (1.0f + __expf(-v)); }
__device__ __forceinline__ float softplus_f(float v) { return v > 20.0f ? v : log1pf(__expf(v)); }
__device__ __forceinline__ void unpack8(const u32x4 w, float* f) {
    f[0] = bf2f(w.x & 0xffffu); f[1] = bf2f(w.x >> 16); f[2] = bf2f(w.y & 0xffffu); f[3] = bf2f(w.y >> 16);
    f[4] = bf2f(w.z & 0xffffu); f[5] = bf2f(w.z >> 16); f[6] = bf2f(w.w & 0xffffu); f[7] = bf2f(w.w >> 16);
}

__device__ __forceinline__ void phase0(const Params& P, int vb, int nb) {
    const int tid = threadIdx.x, lane = tid & 63, wave = tid >> 6;
    bf16_t* XN = (bf16_t*)(P.ws + WS_XN);
    bf16_t* WTIN = (bf16_t*)(P.ws + WS_WTIN);
    bf16_t* WTOUT = (bf16_t*)(P.ws + WS_WTOUT);
    for (int m = vb * 8 + wave; m < MA; m += nb * 8) {
        u32x2* o8 = (u32x2*)(XN + (size_t)m * DM) + lane;
        if (m >= MX + NMETA) {
#pragma unroll
            for (int j = 0; j < 4; ++j) o8[64 * j] = (u32x2){0u, 0u};
        } else {
            const float* src = (m < MX) ? P.x + (size_t)m * DM : P.meta + (size_t)(m - MX) * DM;
            const f32x4* xr = (const f32x4*)src + lane;
            f32x4 v[4]; float ss = 0.f;
#pragma unroll
            for (int j = 0; j < 4; ++j) { v[j] = xr[64 * j]; ss += (v[j].x * v[j].x + v[j].y * v[j].y) + (v[j].z * v[j].z + v[j].w * v[j].w); }
            const float rstd = 1.0f / sqrtf(wave_sum(ss) * (1.0f / DM) + EPS);
#pragma unroll
            for (int j = 0; j < 4; ++j) o8[64 * j] = (u32x2){pk2(v[j].x * rstd, v[j].y * rstd), pk2(v[j].z * rstd, v[j].w * rstd)};
        }
    }
    const int gt = vb * NTHREADS + tid, ngt = nb * NTHREADS;
    for (int id = gt; id < NPAD * (DM / 8); id += ngt) {
        const int n = id % NPAD, kc = id / NPAD;
        u32x4 w = (u32x4){0u, 0u, 0u, 0u};
        if (n < DIN) {
            float f[8];
#pragma unroll
            for (int j = 0; j < 8; ++j) f[j] = P.w_in[(size_t)(8 * kc + j) * DIN + n] * P.norm_w[8 * kc + j];
            w = (u32x4){pk2(f[0], f[1]), pk2(f[2], f[3]), pk2(f[4], f[5]), pk2(f[6], f[7])};
        }
        *(u32x4*)(WTIN + (size_t)n * DM + 8 * kc) = w;
    }
    for (int id = gt; id < DM * (2048 / 8); id += ngt) {
        const int n = id % DM, kc = id / DM;
        float f[8];
#pragma unroll
        for (int j = 0; j < 8; ++j) { const int k = 8 * kc + j; const float s = (k < 1024) ? P.sb_norm_w[k] : P.ssd_norm_w[k - 1024]; f[j] = P.w_out[(size_t)k * DM + n] * s; }
        *(u32x4*)(WTOUT + (size_t)n * 2048 + 8 * kc) = (u32x4){pk2(f[0], f[1]), pk2(f[2], f[3]), pk2(f[4], f[5]), pk2(f[6], f[7])};
    }
}

namespace pg8 {
#define PG8_LAS __attribute__((address_space(3)))
typedef unsigned short bf16_t;
typedef short bf16x8 __attribute__((ext_vector_type(8)));
typedef float f32x4 __attribute__((ext_vector_type(4)));
typedef unsigned u32x4 __attribute__((ext_vector_type(4)));
constexpr int BM = 256, BK = 64, HALF = 128, HTB = HALF * BK * 2  , STAGE_BYTES = 8 * HTB, NXCD = 8, WGM = 8;

__host__ __device__ __forceinline__ int lds_byte(int r, int c) { const int st = (r >> 4) * 2 + (c >> 5), rr = r & 15, cc = c & 31, ob = rr * 64 + cc * 2; return st * 1024 + (ob ^ (((ob >> 9) & 1) << 5)); }
__host__ __device__ __forceinline__ void stage_rc(int b, int& R, int& C) { const int st = b / 1024, sb = b % 1024, swz = sb ^ (((sb >> 9) & 1) << 5); R = (st >> 1) * 16 + swz / 64; C = (st & 1) * 32 + (swz % 64) / 2; }
__host__ __device__ __forceinline__ int perm32(int rho) { const int n = rho >> 4, i = rho & 15; return 8 * (i >> 2) + 4 * n + (i & 3); }

struct Unit { int pm, pn, sw; };
struct Gemm { const bf16_t* A; const bf16_t* Bt; int M, N, K; };

struct StaticOrder {
    int nM, nN, nwg, G, c;
    __host__ __device__ void init(int M, int N, int G_, int c_) { nM = M / BM; nN = N / BM; nwg = nM * nN; G = G_; c = c_; }
    __host__ __device__ bool next(int i, Unit& u) const {
        const long L = (long)i * G + c; if (L >= nwg) return false;
        int wgid = (int)L; { const int q = nwg / NXCD, r = nwg % NXCD, xcd = wgid % NXCD, off = wgid / NXCD; wgid = (xcd < r ? xcd * (q + 1) : r * (q + 1) + (xcd - r) * q) + off; }
        const int nig = WGM * nN, gid = wgid / nig, fm = gid * WGM, gsz = (nM - fm) < WGM ? (nM - fm) : WGM;
        u.pm = fm + ((wgid % nig) % gsz); u.pn = (wgid % nig) / gsz; u.sw = 0; return true;
    }
    __device__ __forceinline__ void a_ready(const Unit&) const {}
    __device__ __forceinline__ void done(const Unit&) const {}
};

__device__ __forceinline__ const char* unit_a(const Gemm& g, const Unit& u, size_t tstep) { return u.sw ? (const char*)g.Bt + (size_t)u.pn * tstep : (const char*)g.A + (size_t)u.pm * tstep; }
__device__ __forceinline__ const char* unit_b(const Gemm& g, const Unit& u, size_t tstep) { return u.sw ? (const char*)g.A + (size_t)u.pm * tstep : (const char*)g.Bt + (size_t)u.pn * tstep; }
template <class Epi, class Sched, bool ALIGN_EPI = false, bool SP2 = false>
__device__ __forceinline__ void gemm_phase(PG8_LAS unsigned char* lds, const Gemm g, const Sched& S, const Epi& E) {
    const int tid = threadIdx.x, wid = __builtin_amdgcn_readfirstlane(tid >> 6), lane = tid & 63, wr = wid >> 2, wc = wid & 3, fr = lane & 15, fq = lane >> 4;
    const int K = g.K, nt = K / BK;
    unsigned voffA[2], voffB[2];
#pragma unroll
    for (int i = 0; i < 2; ++i) { int R, C; stage_rc(tid * 16 + i * 8192, R, C); const int Rb = Epi::PERM ? ((R & ~31) + perm32(R & 31)) : R;
        voffA[i] = (unsigned)(R * K + C) * 2u; voffB[i] = (unsigned)(Rb * K + C) * 2u; }
    const size_t kstep = (size_t)(BK * 2);
    const size_t hstep = (size_t)HALF * K * 2;
    const size_t tstep = 2 * hstep;
    const unsigned ldsw = (unsigned)wid * 1024u;
    const int aoff = lds_byte(wr * 64 + fr, fq * 8), boff = lds_byte(wc * 32 + fr, fq * 8);
#define PG8_SA(b, h) (((b) * 2 + (h)) * HTB)
#define PG8_SB(b, h) ((4 + (b) * 2 + (h)) * HTB)
#define PG8_STAGE(bufoff, gbase, voff) do { _Pragma("unroll") for (int _i = 0; _i < 2; ++_i) \
        __builtin_amdgcn_global_load_lds((const unsigned*)((const char*)(gbase) + (voff)[_i]), (PG8_LAS unsigned*)(lds + (bufoff) + ldsw + _i * 8192), 16, 0, 0); } while (0)
#define PG8_LDA(dst, b, h) do { _Pragma("unroll") for (int m = 0; m < 4; ++m) _Pragma("unroll") for (int k = 0; k < 2; ++k) dst[m][k] = *(const PG8_LAS bf16x8*)(lds + PG8_SA(b, h) + aoff + m * 2048 + k * 1024); } while (0)
#define PG8_LDB(dst, b, h) do { _Pragma("unroll") for (int n = 0; n < 2; ++n) _Pragma("unroll") for (int k = 0; k < 2; ++k) dst[n][k] = *(const PG8_LAS bf16x8*)(lds + PG8_SB(b, h) + boff + n * 2048 + k * 1024); } while (0)
#define PG8_MMA(ai, bj, At, Bt) do { __builtin_amdgcn_s_setprio(1); _Pragma("unroll") for (int m = 0; m < 4; ++m) _Pragma("unroll") for (int n = 0; n < 2; ++n) _Pragma("unroll") for (int k = 0; k < 2; ++k) \
        acc[ai][bj][m][n] = __builtin_amdgcn_mfma_f32_16x16x32_bf16(Bt[n][k], At[m][k], acc[ai][bj][m][n], 0, 0, 0); __builtin_amdgcn_s_setprio(0); } while (0)
#define PG8_WAIT_V(n) asm volatile("s_waitcnt vmcnt(" #n ")" ::: "memory")
#define PG8_WAIT_L(n) asm volatile("s_waitcnt lgkmcnt(" #n ")" ::: "memory")
#define PG8_BAR __builtin_amdgcn_s_barrier()
#define PG8_SCHED __builtin_amdgcn_sched_barrier(0)
    Unit cur, nxt; int ui = 0;
    if (!S.next(0, cur)) return;
    f32x4 acc[2][2][4][2];
#pragma unroll
    for (int a = 0; a < 2; ++a)
#pragma unroll
        for (int b = 0; b < 2; ++b)
#pragma unroll
            for (int m = 0; m < 4; ++m)
#pragma unroll
                for (int n = 0; n < 2; ++n) acc[a][b][m][n] = (f32x4){0.f, 0.f, 0.f, 0.f};
    bf16x8 At[4][2], B0[2][2], B1[2][2];
    const char* cA = unit_a(g, cur, tstep); const char* cB = unit_b(g, cur, tstep);
    S.a_ready(cur);
    if constexpr (SP2) {
        PG8_STAGE(PG8_SB(0, 0), cB, voffB); PG8_STAGE(PG8_SB(0, 1), cB + hstep, voffB); PG8_STAGE(PG8_SA(0, 0), cA, voffA); PG8_STAGE(PG8_SA(0, 1), cA + hstep, voffA);
        if (wr == 1) PG8_BAR;
        PG8_WAIT_V(2); PG8_BAR;
        PG8_STAGE(PG8_SB(1, 0), cB + kstep, voffB); PG8_STAGE(PG8_SA(1, 0), cA + kstep, voffA); PG8_STAGE(PG8_SB(1, 1), cB + hstep + kstep, voffB);
        PG8_WAIT_V(6); PG8_BAR;
    } else {
        PG8_STAGE(PG8_SB(0, 0), cB, voffB); PG8_STAGE(PG8_SA(0, 0), cA, voffA); PG8_STAGE(PG8_SB(0, 1), cB + hstep, voffB); PG8_STAGE(PG8_SA(0, 1), cA + hstep, voffA);
        if (wr == 1) PG8_BAR;
        PG8_WAIT_V(4); PG8_BAR;
        PG8_STAGE(PG8_SB(1, 0), cB + kstep, voffB); PG8_STAGE(PG8_SA(1, 0), cA + kstep, voffA); PG8_STAGE(PG8_SB(1, 1), cB + hstep + kstep, voffB);
        PG8_WAIT_V(6); PG8_BAR;
    }
    for (;;) {
        const bool has_next = S.next(ui + 1, nxt);
        const char* nA = has_next ? unit_a(g, nxt, tstep) : cA; const char* nB = has_next ? unit_b(g, nxt, tstep) : cB;
        for (int t = 0; t < nt; t += 2) {
            const bool last = (t == nt - 2);
            const char* a1 = cA + (size_t)(t + 1) * kstep;
            const char* a2 = last ? nA : cA + (size_t)(t + 2) * kstep; const char* b2 = last ? nB : cB + (size_t)(t + 2) * kstep;
            const char* a3 = a2 + kstep; const char* b3 = b2 + kstep;
            if (last && has_next) S.a_ready(nxt);
            if constexpr (Epi::HAS_MID) { if (t == nt / 2) E.mid(acc, wr, fr); }
            if constexpr (SP2) {
            PG8_LDB(B0, 0, 0); PG8_LDB(B1, 0, 1); PG8_SCHED; PG8_LDA(At, 0, 0); PG8_STAGE(PG8_SA(1, 1), a1 + hstep, voffA);
            PG8_WAIT_V(8); PG8_WAIT_L(0); PG8_BAR; PG8_MMA(0, 0, At, B0); PG8_MMA(0, 1, At, B1); PG8_BAR; PG8_SCHED;
            PG8_LDA(At, 0, 1); PG8_STAGE(PG8_SB(0, 0), b2, voffB); PG8_STAGE(PG8_SB(0, 1), b2 + hstep, voffB); PG8_STAGE(PG8_SA(0, 0), a2, voffA);
            PG8_WAIT_V(8); PG8_WAIT_L(0); PG8_BAR; PG8_MMA(1, 0, At, B0); PG8_MMA(1, 1, At, B1); PG8_BAR; PG8_SCHED;
            PG8_LDB(B0, 1, 0); PG8_LDB(B1, 1, 1); PG8_SCHED; PG8_LDA(At, 1, 0); PG8_STAGE(PG8_SA(0, 1), a2 + hstep, voffA);
            PG8_WAIT_V(8); PG8_WAIT_L(0); PG8_BAR; PG8_MMA(0, 0, At, B0); PG8_MMA(0, 1, At, B1); PG8_BAR; PG8_SCHED;
            PG8_LDA(At, 1, 1); PG8_STAGE(PG8_SB(1, 0), b3, voffB); PG8_STAGE(PG8_SB(1, 1), b3 + hstep, voffB); PG8_STAGE(PG8_SA(1, 0), a3, voffA);
            PG8_WAIT_V(8); PG8_WAIT_L(0); PG8_BAR; PG8_MMA(1, 0, At, B0); PG8_MMA(1, 1, At, B1); PG8_BAR; PG8_SCHED;
            } else {
            PG8_LDB(B0, 0, 0); PG8_SCHED; PG8_LDA(At, 0, 0); PG8_STAGE(PG8_SA(1, 1), a1 + hstep, voffA);
            PG8_WAIT_L(8); PG8_BAR; PG8_WAIT_L(0); PG8_MMA(0, 0, At, B0); PG8_BAR; PG8_SCHED;
            PG8_LDB(B1, 0, 1); PG8_STAGE(PG8_SB(0, 0), b2, voffB);
            PG8_BAR; PG8_WAIT_L(0); PG8_MMA(0, 1, At, B1); PG8_BAR;
            PG8_LDA(At, 0, 1); PG8_STAGE(PG8_SA(0, 0), a2, voffA);
            PG8_BAR; PG8_WAIT_L(0); PG8_MMA(1, 0, At, B0); PG8_BAR; PG8_SCHED;
            PG8_STAGE(PG8_SB(0, 1), b2 + hstep, voffB);
            PG8_WAIT_V(6); PG8_BAR; PG8_MMA(1, 1, At, B1); PG8_BAR;
            PG8_LDB(B0, 1, 0); PG8_SCHED; PG8_LDA(At, 1, 0); PG8_STAGE(PG8_SA(0, 1), a2 + hstep, voffA);
            PG8_WAIT_L(8); PG8_BAR; PG8_WAIT_L(0); PG8_MMA(0, 0, At, B0); PG8_BAR; PG8_SCHED;
            PG8_LDB(B1, 1, 1); PG8_STAGE(PG8_SB(1, 0), b3, voffB);
            PG8_BAR; PG8_WAIT_L(0); PG8_MMA(0, 1, At, B1); PG8_BAR;
            PG8_LDA(At, 1, 1); PG8_STAGE(PG8_SA(1, 0), a3, voffA);
            PG8_BAR; PG8_WAIT_L(0); PG8_MMA(1, 0, At, B0); PG8_BAR; PG8_SCHED;
            PG8_STAGE(PG8_SB(1, 1), b3 + hstep, voffB);
            PG8_WAIT_V(6); PG8_BAR; PG8_MMA(1, 1, At, B1); PG8_BAR;
            }
        }
        if constexpr (ALIGN_EPI) { if (wr == 0) PG8_BAR; }
        if constexpr (!Epi::AFTER_DRAIN) { E(acc, cur, wr, wc, fr, fq); S.done(cur); }
        if (!has_next) break;
#pragma unroll
        for (int a = 0; a < 2; ++a)
#pragma unroll
            for (int b = 0; b < 2; ++b)
#pragma unroll
                for (int m = 0; m < 4; ++m)
#pragma unroll
                    for (int n = 0; n < 2; ++n) acc[a][b][m][n] = (f32x4){0.f, 0.f, 0.f, 0.f};
        cur = nxt; cA = nA; cB = nB; ++ui;
        if constexpr (ALIGN_EPI) { if (wr == 1) PG8_BAR; }
    }
    PG8_WAIT_V(0);
    if constexpr (!ALIGN_EPI) { if (wr == 0) PG8_BAR; }
    PG8_BAR;
    if constexpr (Epi::AFTER_DRAIN) { E.fused(acc, cur, wr, wc, fr, fq, lds, wid, lane); S.done(cur); }
#undef PG8_SA
#undef PG8_SB
#undef PG8_STAGE
#undef PG8_LDA
#undef PG8_LDB
#undef PG8_MMA
#undef PG8_WAIT_V
#undef PG8_WAIT_L
#undef PG8_BAR
#undef PG8_SCHED
}
}

__device__ __forceinline__ unsigned cvt_pk_bf16(float lo, float hi) { unsigned r; asm volatile("v_cvt_pk_bf16_f32 %0, %1, %2" : "=v"(r) : "v"(lo), "v"(hi)); return r; }
__device__ __forceinline__ u32x4 pack8(const f32x4 v0, const f32x4 v1) { u32x4 w; w.x = cvt_pk_bf16(v0[0], v0[1]); w.y = cvt_pk_bf16(v0[2], v0[3]); w.z = cvt_pk_bf16(v1[0], v1[1]); w.w = cvt_pk_bf16(v1[2], v1[3]); return w; }
__device__ __forceinline__ f32x4 silu4(const f32x4 v) { f32x4 o;
#pragma unroll
    for (int j = 0; j < 4; ++j) o[j] = v[j] * __builtin_amdgcn_rcpf(1.0f + __expf(-v[j]));
    return o; }

struct Order1 {
    int G, c;
    __device__ __forceinline__ bool next(int i, pg8::Unit& u) const {
        constexpr int nM = 64, nN = 27, nwg = nM * nN;
        const int L = i * G + c;
        if (L < nwg) { const int xcd = L % 8, off = L / 8, wgid = xcd * (nwg / 8) + off; const int nig = 8 * nN, gid = wgid / nig, fm = gid * 8;
            u.pm = fm + ((wgid % nig) % 8); u.pn = (wgid % nig) / 8; u.sw = (u.pn >= 8 && u.pn < 12) ? 1 : 0; return true; }
        const int j = L - nwg; if (j >= 15) return false;
        u.pm = 64; u.pn = j < 8 ? 4 + j : 12 + j; u.sw = (u.pn >= 8 && u.pn < 12) ? 1 : 0; return true;
    }
    __device__ __forceinline__ void a_ready(const pg8::Unit&) const {}
    __device__ __forceinline__ void done(const pg8::Unit&) const {}
};

struct Epi1M {
    static constexpr bool PERM = true, AFTER_DRAIN = false, HAS_MID = false;
    bf16_t *Q, *KB, *VT, *GZ, *XBC; float* DT; const float* dt_bias;
    __device__ __forceinline__ void mid(f32x4 (&)[2][2][4][2], int, int) const {}
    __device__ __forceinline__ void operator()(const f32x4 (&acc)[2][2][4][2], const pg8::Unit& u, int wr, int wc, int fr, int fq) const {
        const int pn = u.pn, pm = u.pm;
        asm volatile("" : "+v"(fr), "+v"(fq));
        const int rl0 = wr * 64 + fr, cl0 = wc * 32 + 8 * fq;
        if (u.sw) {
            const int vc0 = (pn - 8) * 256 + rl0;
            if (pm < 64) {
                const int b = pm >> 3, i0 = (pm & 7) * 256 + cl0;
#pragma unroll
                for (int ai = 0; ai < 2; ++ai)
#pragma unroll
                    for (int m = 0; m < 4; ++m) { bf16_t* rowp = VT + ((size_t)(b * 1024 + vc0 + ai * 128 + m * 16)) * LT + NMETA + i0;
#pragma unroll
                        for (int bj = 0; bj < 2; ++bj) *(u32x4*)(rowp + bj * 128) = pack8(acc[ai][bj][m][0], acc[ai][bj][m][1]); }
            } else if (wc == 0 && fq < 2) {
#pragma unroll
                for (int ai = 0; ai < 2; ++ai)
#pragma unroll
                    for (int m = 0; m < 4; ++m) { const u32x4 w = pack8(acc[ai][0][m][0], acc[ai][0][m][1]);
                        _Pragma("unroll 1") for (int b = 0; b < NB; ++b) *(u32x4*)(VT + ((size_t)(b * 1024 + vc0 + ai * 128 + m * 16)) * LT + 8 * fq) = w; }
            }
            return;
        }
        if (pm < 64) {
            const int b = pm >> 3;
            if (pn < 4) {
#pragma unroll
                for (int ai = 0; ai < 2; ++ai)
#pragma unroll
                    for (int m = 0; m < 4; ++m) { bf16_t* rowp = Q + (size_t)(pm * 256 + rl0 + ai * 128 + m * 16) * 1024 + pn * 256 + cl0;
#pragma unroll
                        for (int bj = 0; bj < 2; ++bj) *(u32x4*)(rowp + bj * 128) = pack8(acc[ai][bj][m][0] * 0.125f, acc[ai][bj][m][1] * 0.125f); }
            } else if (pn < 8) {
#pragma unroll
                for (int ai = 0; ai < 2; ++ai)
#pragma unroll
                    for (int m = 0; m < 4; ++m) { bf16_t* rowp = KB + (size_t)(pm * 256 + rl0 + ai * 128 + m * 16 + NMETA * (b + 1)) * 1024 + (pn - 4) * 256 + cl0;
#pragma unroll
                        for (int bj = 0; bj < 2; ++bj) *(u32x4*)(rowp + bj * 128) = pack8(acc[ai][bj][m][0], acc[ai][bj][m][1]); }
            } else if (pn < 20) {
#pragma unroll
                for (int ai = 0; ai < 2; ++ai)
#pragma unroll
                    for (int m = 0; m < 4; ++m) { bf16_t* rowp = GZ + (size_t)(pm * 256 + rl0 + ai * 128 + m * 16) * 2048 + (pn - 12) * 256 + cl0;
#pragma unroll
                        for (int bj = 0; bj < 2; ++bj) *(u32x4*)(rowp + bj * 128) = pack8(silu4(acc[ai][bj][m][0]), silu4(acc[ai][bj][m][1])); }
            } else if (pn < 26) {
#pragma unroll
                for (int ai = 0; ai < 2; ++ai)
#pragma unroll
                    for (int m = 0; m < 4; ++m) { bf16_t* rowp = XBC + (size_t)(pm * 256 + rl0 + ai * 128 + m * 16 + NMETA * (b + 1)) * XBCW + (pn - 20) * 256 + cl0;
#pragma unroll
                        for (int bj = 0; bj < 2; ++bj) *(u32x4*)(rowp + bj * 128) = pack8(acc[ai][bj][m][0], acc[ai][bj][m][1]); }
            } else if (wc == 0 && fq < 2) {
                const f32x4 b0 = *(const f32x4*)(dt_bias + 8 * fq), b1 = *(const f32x4*)(dt_bias + 8 * fq + 4);
#pragma unroll
                for (int ai = 0; ai < 2; ++ai)
#pragma unroll
                    for (int m = 0; m < 4; ++m) { float* rowp = DT + (size_t)(pm * 256 + rl0 + ai * 128 + m * 16 + NMETA * (b + 1)) * 16 + 8 * fq;
                        f32x4 o0, o1;
#pragma unroll
                        for (int j = 0; j < 4; ++j) { o0[j] = softplus_f(acc[ai][0][m][0][j] + b0[j]); o1[j] = softplus_f(acc[ai][0][m][1][j] + b1[j]); }
                        *(f32x4*)rowp = o0; *(f32x4*)(rowp + 4) = o1; }
            }
            return;
        }
        if (wr != 0) return;
        if (pn < 8) {
            _Pragma("unroll 1") for (int b = 0; b < NB; ++b) { bf16_t* rowp = KB + (size_t)(b * LT + fr) * 1024 + (pn - 4) * 256 + cl0;
#pragma unroll
                for (int bj = 0; bj < 2; ++bj) *(u32x4*)(rowp + bj * 128) = pack8(acc[0][bj][0][0], acc[0][bj][0][1]); }
        } else if (pn < 26) {
            _Pragma("unroll 1") for (int b = 0; b < NB; ++b) { bf16_t* rowp = XBC + (size_t)(b * LT + fr) * XBCW + (pn - 20) * 256 + cl0;
#pragma unroll
                for (int bj = 0; bj < 2; ++bj) *(u32x4*)(rowp + bj * 128) = pack8(acc[0][bj][0][0], acc[0][bj][0][1]); }
        } else if (wc == 0 && fq < 2) {
            const f32x4 b0 = *(const f32x4*)(dt_bias + 8 * fq), b1 = *(const f32x4*)(dt_bias + 8 * fq + 4);
            f32x4 o0, o1;
#pragma unroll
            for (int j = 0; j < 4; ++j) { o0[j] = softplus_f(acc[0][0][0][0][j] + b0[j]); o1[j] = softplus_f(acc[0][0][0][1][j] + b1[j]); }
            _Pragma("unroll 1") for (int b = 0; b < NB; ++b) { float* rowp = DT + (size_t)(b * LT + fr) * 16 + 8 * fq; *(f32x4*)rowp = o0; *(f32x4*)(rowp + 4) = o1; }
        }
    }
};

__device__ __forceinline__ void row_rstd(const float* SSQ, int m, float& rs_sb, float& rs_ssd) {
    const f32x4* p = (const f32x4*)(SSQ + (size_t)m * 32);
    float s1 = 0.f, s2 = 0.f;
#pragma unroll
    for (int j = 0; j < 4; ++j) { const f32x4 a = p[j], b = p[4 + j]; s1 += (a.x + a.y) + (a.z + a.w); s2 += (b.x + b.y) + (b.z + b.w); }
    rs_sb = 1.0f / sqrtf(s1 * (1.0f / 1024.0f) + EPS); rs_ssd = 1.0f / sqrtf(s2 * (1.0f / 1024.0f) + EPS);
}


struct Epi2M {
    static constexpr bool PERM = false, AFTER_DRAIN = false, HAS_MID = true;
    const float* x; float* out; const PG8_LAS float* RS;
    __device__ __forceinline__ void mid(f32x4 (&acc)[2][2][4][2], int wr, int fr) const {
#pragma unroll
        for (int ai = 0; ai < 2; ++ai)
#pragma unroll
            for (int m = 0; m < 4; ++m) { const float r = RS[2 * (ai * 128 + wr * 64 + m * 16 + fr)];
#pragma unroll
                for (int bj = 0; bj < 2; ++bj)
#pragma unroll
                    for (int n = 0; n < 2; ++n) acc[ai][bj][m][n] *= r; }
    }
    __device__ __forceinline__ void operator()(const f32x4 (&acc)[2][2][4][2], const pg8::Unit& u, int wr, int wc, int fr, int fq) const {
        const int col0 = u.pn * 256 + wc * 32 + 4 * fq;
#pragma unroll
        for (int ai = 0; ai < 2; ++ai)
#pragma unroll
            for (int m = 0; m < 4; ++m) { const int r = ai * 128 + wr * 64 + m * 16 + fr; const float rs = RS[2 * r + 1]; const size_t off = (size_t)(u.pm * 256 + r) * DM + col0;
#pragma unroll
                for (int bj = 0; bj < 2; ++bj)
#pragma unroll
                    for (int n = 0; n < 2; ++n) { const f32x4 xv = *(const f32x4*)(x + off + bj * 128 + n * 16); *(f32x4*)(out + off + bj * 128 + n * 16) = xv + acc[ai][bj][m][n] * rs; } }
    }
};

__device__ __forceinline__ void attn_simple(const Params& P, float* lds, int vb, int nb) {
    const bf16_t* Q = (const bf16_t*)P.out;
    const bf16_t* KB = (const bf16_t*)(P.ws + WS_KB);
    const bf16_t* VT = (const bf16_t*)(P.ws + WS_VT);
    bf16_t* GZ = (bf16_t*)(P.ws + WS_GZ);
    float* SSQ = (float*)(P.ws + WS_SSQ);
    float* Ks = lds; float* Vs = lds + 64 * 64;
    const int tid = threadIdx.x;
    for (int unit = vb; unit < NB * 16 * 4; unit += nb) {
        const int qb = 3 - (unit & 3), h = (unit >> 2) & 15, b = unit >> 6;
        const int i = qb * 512 + tid, t = NMETA + i, m = b * SEQ + i;
        float q[64], o[64];
#pragma unroll
        for (int c = 0; c < 8; ++c) { const u32x4 w = *(const u32x4*)(Q + (size_t)m * 1024 + h * 64 + 8 * c); unpack8(w, q + 8 * c); }
#pragma unroll
        for (int d = 0; d < 64; ++d) o[d] = 0.f;
        float carry = 0.f;
        const int t_hi = NMETA + qb * 512 + 511;
        for (int kt = (t_hi - 1) >> 6; kt >= 0; --kt) {
            __syncthreads();
            { const int key = tid >> 3, dc = tid & 7, s = 64 * kt + key;
              u32x4 w = (u32x4){0u, 0u, 0u, 0u};
              if (s < LT) w = *(const u32x4*)(KB + ((size_t)b * LT + s) * 1024 + h * 64 + 8 * dc);
              float f[8]; unpack8(w, f);
#pragma unroll
              for (int j = 0; j < 8; ++j) Ks[key * 64 + 8 * dc + j] = f[j];
              const int d = tid >> 3, sc = tid & 7, s8 = 64 * kt + 8 * sc;
              w = (u32x4){0u, 0u, 0u, 0u};
              if (s8 < LT) w = *(const u32x4*)(VT + ((size_t)b * 1024 + h * 64 + d) * LT + s8);
              unpack8(w, f);
#pragma unroll
              for (int j = 0; j < 8; ++j) Vs[(8 * sc + j) * 64 + d] = f[j]; }
            __syncthreads();
            for (int sl = 63; sl >= 0; --sl) {
                const int s = 64 * kt + sl;
                if (s < t) {
                    float z = 0.f;
#pragma unroll
                    for (int d = 0; d < 64; d += 4) { const f32x4 kv = *(const f32x4*)(Ks + sl * 64 + d); z += q[d] * kv.x + q[d + 1] * kv.y + q[d + 2] * kv.z + q[d + 3] * kv.w; }
                    const float ls = -softplus_f(z);
                    const float w = __expf(z + ls + carry);
                    carry += ls;
#pragma unroll
                    for (int d = 0; d < 64; d += 4) { const f32x4 vv = *(const f32x4*)(Vs + sl * 64 + d); o[d] += w * vv.x; o[d + 1] += w * vv.y; o[d + 2] += w * vv.z; o[d + 3] += w * vv.w; }
                }
            }
        }
        float ss = 0.f;
#pragma unroll
        for (int c = 0; c < 8; ++c) {
            u32x4* gp = (u32x4*)(GZ + (size_t)m * 2048 + h * 64 + 8 * c);
            float g[8]; unpack8(*gp, g);
#pragma unroll
            for (int j = 0; j < 8; ++j) { g[j] *= o[8 * c + j]; ss += g[j] * g[j]; }
            *gp = (u32x4){pk2(g[0], g[1]), pk2(g[2], g[3]), pk2(g[4], g[5]), pk2(g[6], g[7])};
        }
        SSQ[(size_t)m * 32 + h] = ss;
    }
}

__device__ __forceinline__ void ssd_simple(const Params& P, float* lds, int vb, int nb) {
    const bf16_t* XBC = (const bf16_t*)(P.ws + WS_XBC);
    const float* DT = (const float*)(P.ws + WS_DT);
    bf16_t* GZ = (bf16_t*)(P.ws + WS_GZ);
    float* SSQ = (float*)(P.ws + WS_SSQ);
    float* xs_l = lds; float* B_l = lds + 16 * 512; float* C_l = B_l + 16 * 128; float* dt_l = C_l + 16 * 128;
    const int tid = threadIdx.x, lane = tid & 63, r = tid >> 6;
    for (int unit = vb; unit < NB * 2; unit += nb) {
        const int b = unit >> 1, g = unit & 1, hh = g * 8 + r;
        const float a = -__expf(P.a_log[hh]), Dk = P.d_skip[hh];
        float hs[128];
#pragma unroll
        for (int n = 0; n < 128; ++n) hs[n] = 0.f;
        for (int t0 = 0; t0 < LT; t0 += 16) {
            __syncthreads();
            for (int id = tid; id < 16 * 768; id += NTHREADS) {
                const int tt = id / 768, cc = id % 768, t = t0 + tt;
                int c; float* dst;
                if (cc < 512) { c = g * 512 + cc; dst = xs_l + tt * 512 + cc; }
                else if (cc < 640) { c = 1024 + g * 128 + (cc - 512); dst = B_l + tt * 128 + (cc - 512); }
                else { c = 1280 + g * 128 + (cc - 640); dst = C_l + tt * 128 + (cc - 640); }
                float v = P.conv_b[c];
#pragma unroll
                for (int j = 0; j < 4; ++j) { const int ts = t - 3 + j; if (ts >= 0) v += P.conv_w[j * XBCW + c] * bf2f(XBC[((size_t)b * LT + ts) * XBCW + c]); }
                *dst = silu_f(v);
            }
            if (tid < 128) dt_l[tid] = DT[((size_t)b * LT + t0 + (tid >> 3)) * 16 + g * 8 + (tid & 7)];
            __syncthreads();
#pragma unroll 1
            for (int tt = 0; tt < 16; ++tt) {
                const float dtv = dt_l[tt * 8 + r], dA = __expf(dtv * a), xv = xs_l[tt * 512 + r * 64 + lane], dtx = dtv * xv;
                float y = 0.f;
#pragma unroll
                for (int n = 0; n < 128; n += 4) {
                    const f32x4 bv = *(const f32x4*)(B_l + tt * 128 + n), cv = *(const f32x4*)(C_l + tt * 128 + n);
                    hs[n] = hs[n] * dA + dtx * bv.x; y += cv.x * hs[n];
                    hs[n + 1] = hs[n + 1] * dA + dtx * bv.y; y += cv.y * hs[n + 1];
                    hs[n + 2] = hs[n + 2] * dA + dtx * bv.z; y += cv.z * hs[n + 2];
                    hs[n + 3] = hs[n + 3] * dA + dtx * bv.w; y += cv.w * hs[n + 3];
                }
                y += Dk * xv;
                const int t = t0 + tt;
                if (t >= NMETA) {
                    const size_t m = (size_t)b * SEQ + (t - NMETA);
                    bf16_t* gp = GZ + m * 2048 + 1024 + hh * 64 + lane;
                    const float gv = y * bf2f(*gp);
                    *gp = (bf16_t)f2bf(gv);
                    const float ss = wave_sum(gv * gv);
                    if (lane == 0) SSQ[m * 32 + 16 + hh] = ss;
                }
            }
        }
    }
}

__device__ __forceinline__ void final_norm(const Params& P, int vb, int nb) {
    const int tid = threadIdx.x, lane = tid & 63, wave = tid >> 6;
    for (int m = vb * 8 + wave; m < MX; m += nb * 8) {
        f32x4* xr = (f32x4*)(P.out + (size_t)m * DM) + lane;
        const f32x4* wr = (const f32x4*)P.final_w + lane;
        f32x4 v[4]; float ss = 0.f;
#pragma unroll
        for (int j = 0; j < 4; ++j) { v[j] = xr[64 * j]; ss += (v[j].x * v[j].x + v[j].y * v[j].y) + (v[j].z * v[j].z + v[j].w * v[j].w); }
        const float rstd = 1.0f / sqrtf(wave_sum(ss) * (1.0f / DM) + EPS);
#pragma unroll
        for (int j = 0; j < 4; ++j) { const f32x4 w = wr[64 * j]; xr[64 * j] = (f32x4){v[j].x * rstd * w.x, v[j].y * rstd * w.y, v[j].z * rstd * w.z, v[j].w * rstd * w.w}; }
    }
}

__global__ void __launch_bounds__(NTHREADS, 2) hybrid_fwd(Params P) {
    extern __shared__ __attribute__((aligned(16))) unsigned char lds_raw[];
    float* lds = (float*)lds_raw;
    PG8_LAS unsigned char* ldsl = (PG8_LAS unsigned char*)lds_raw;
    cg::grid_group grid = cg::this_grid();
    const int vb = blockIdx.x, nb = gridDim.x;
    const int lo = P.ph_lo, hi = P.ph_hi;
#define IN(k) (lo <= (k) && (k) < hi)
#define BOTH(k) (IN(k) && IN((k) + 1))
    if (IN(0)) { phase0(P, vb, nb); if (BOTH(0)) grid.sync(); }
    if (IN(1)) {
        pg8::Gemm g{(const bf16_t*)(P.ws + WS_XN), (const bf16_t*)(P.ws + WS_WTIN), MA, NPAD, DM};
        Order1 S{nb, vb};
        Epi1M E{(bf16_t*)P.out, (bf16_t*)(P.ws + WS_KB), (bf16_t*)(P.ws + WS_VT), (bf16_t*)(P.ws + WS_GZ), (bf16_t*)(P.ws + WS_XBC), (float*)(P.ws + WS_DT), P.dt_bias};
        pg8::gemm_phase<Epi1M, Order1, true, true>(ldsl, g, S, E);
        if (BOTH(1)) grid.sync();
    }
    if (IN(2)) {
        if (vb < NB * 2) ssd_simple(P, lds, vb, nb);
        else attn_simple(P, lds, vb - NB * 2, nb - NB * 2);
        if (BOTH(2)) grid.sync();
    }
    if (IN(3)) {
        pg8::Gemm g{(const bf16_t*)(P.ws + WS_GZ), (const bf16_t*)(P.ws + WS_WTOUT), MX, DM, 2048};
        pg8::StaticOrder S; S.init(MX, DM, nb, vb);
        PG8_LAS float* RS = (PG8_LAS float*)(ldsl + pg8::STAGE_BYTES);
        pg8::Unit u0;
        if (S.next(0, u0) && threadIdx.x < 256) { float a, b; row_rstd((const float*)(P.ws + WS_SSQ), u0.pm * 256 + threadIdx.x, a, b); RS[2 * threadIdx.x] = a / b; RS[2 * threadIdx.x + 1] = b; }
        __syncthreads();
        Epi2M E{P.x, P.out, RS};
        pg8::gemm_phase<Epi2M, pg8::StaticOrder, false, true>(ldsl, g, S, E);
        if (BOTH(3)) grid.sync();
    }
    if (IN(4)) final_norm(P, vb, nb);
#undef IN
#undef BOTH
}

#ifndef MK_N_LAUNCHES
#define MK_N_LAUNCHES 1
#endif

extern "C" void kernel_launch(void* const* d_in, const int* in_sizes, int n_in, void* d_out, int out_size, void* d_ws, size_t ws_size, hipStream_t stream) {
    static int grid = 0;
    if (grid == 0) {
        if (n_in != 13 || out_size != MX * DM || ws_size < WS_END) { fprintf(stderr, "kernel_launch: unexpected sizes (n_in %d out %d ws %zu)\n", n_in, out_size, ws_size); grid = -1; return; }
        int dev = 0, cus = 0, per_cu = 0;
        (void)hipGetDevice(&dev);
        (void)hipDeviceGetAttribute(&cus, hipDeviceAttributeMultiprocessorCount, dev);
        (void)hipFuncSetAttribute((const void*)hybrid_fwd, hipFuncAttributeMaxDynamicSharedMemorySize, LDS_BYTES);
        (void)hipOccupancyMaxActiveBlocksPerMultiprocessor(&per_cu, (const void*)hybrid_fwd, NTHREADS, LDS_BYTES);
        if (per_cu < 1) { fprintf(stderr, "kernel_launch: occupancy query says %d blocks per CU\n", per_cu); grid = -1; return; }
        grid = cus;
    }
    if (grid < 0) return;
    Params p{};
    p.x = (const float*)d_in[0]; p.meta = (const float*)d_in[1]; p.norm_w = (const float*)d_in[2]; p.w_in = (const float*)d_in[3];
    p.conv_w = (const float*)d_in[4]; p.conv_b = (const float*)d_in[5]; p.dt_bias = (const float*)d_in[6]; p.a_log = (const float*)d_in[7];
    p.d_skip = (const float*)d_in[8]; p.sb_norm_w = (const float*)d_in[9]; p.ssd_norm_w = (const float*)d_in[10]; p.w_out = (const float*)d_in[11];
    p.final_w = (const float*)d_in[12]; p.out = (float*)d_out; p.ws = (unsigned char*)d_ws;
#if MK_N_LAUNCHES == 1
    p.ph_lo = 0; p.ph_hi = 5;
    void* args[] = {&p};
    hipError_t e = hipLaunchCooperativeKernel((const void*)hybrid_fwd, dim3(grid), dim3(NTHREADS), args, LDS_BYTES, stream);
    if (e != hipSuccess) fprintf(stderr, "cooperative launch failed: %s (grid %d)\n", hipGetErrorString(e), grid);
#else
    for (int ph = 0; ph < 5; ++ph) { p.ph_lo = ph; p.ph_hi = ph + 1; hipLaunchKernelGGL(hybrid_fwd, dim3(grid), dim3(NTHREADS), LDS_BYTES, stream, p); }
#endif
}
```

```cpp
#include <hip/hip_runtime.h>
#include <hip/hip_cooperative_groups.h>
#include <cstdio>
#include <cstdint>
namespace cg = cooperative_groups;

typedef unsigned short bf16_t;
typedef unsigned u32x4 __attribute__((ext_vector_type(4)));
typedef unsigned u32x2 __attribute__((ext_vector_type(2)));
typedef float f32x4 __attribute__((ext_vector_type(4)));

constexpr int DM = 1024, NB = 8, SEQ = 2048, NMETA = 16, LT = SEQ + NMETA  ;
constexpr int MX = NB * SEQ;
constexpr int MA = 16640;
constexpr int DIN = 6672, NPAD = 6912;
constexpr int XBCW = 1536;
constexpr float EPS = 1e-5f;
constexpr int NTHREADS = 512;

constexpr size_t MiB = 1u << 20;
constexpr size_t WS_CTL = 0;
constexpr size_t WS_WTOUT = 1 * MiB;
constexpr size_t WS_DT = 5 * MiB;
constexpr size_t WS_SSQ = 7 * MiB;
constexpr size_t WS_KB = 11 * MiB;
constexpr size_t WS_VT = 44 * MiB;
constexpr size_t WS_GZ = 77 * MiB;
constexpr size_t WS_XBC = 141 * MiB;
constexpr size_t WS_WTIN = 210 * MiB;
constexpr size_t WS_XN = 223 * MiB + MiB / 2;
constexpr size_t WS_XT = 190 * MiB;
constexpr size_t WS_XC = 223 * MiB;
constexpr size_t WS_END = 256 * MiB;
constexpr size_t DO_BC = 32 * MiB, DO_BT = 48 * MiB + MiB / 2, DO_DTP = 57 * MiB;
constexpr int LP = 2112;

constexpr int LDS_BYTES = 147456;

struct Params {
    const float *x, *meta, *norm_w, *w_in, *conv_w, *conv_b, *dt_bias, *a_log, *d_skip, *sb_norm_w, *ssd_norm_w, *w_out, *final_w;
    float* out; unsigned char* ws; int ph_lo, ph_hi;
};

__device__ __forceinline__ float bf2f(unsigned v) { return __uint_as_float(v << 16); }
__device__ __forceinline__ unsigned f2bf(float f) { unsigned u = __float_as_uint(f); return (u + 0x7fffu + ((u >> 16) & 1u)) >> 16; }
__device__ __forceinline__ unsigned pk2(float lo, float hi) { return f2bf(lo) | (f2bf(hi) << 16); }
typedef float f32x2_t __attribute__((ext_vector_type(2))); typedef __bf16 bf16x2_t __attribute__((ext_vector_type(2)));
__device__ __forceinline__ unsigned cvtpk(float lo, float hi) { const f32x2_t v = {lo, hi}; const bf16x2_t b = __builtin_convertvector(v, bf16x2_t); return __builtin_bit_cast(unsigned, b); }
__device__ __forceinline__ float wave_sum(float v) {
#pragma unroll
    for (int o = 1; o < 64; o <<= 1) v += __shfl_xor(v, o);
    return v;
}
__device__ __forceinline__ float silu_f(float v) { return v / (1.0f + __expf(-v)); }
__device__ __forceinline__ float softplus_f(float v) { return v > 20.0f ? v : log1pf(__expf(v)); }
__device__ __forceinline__ void unpack8(const u32x4 w, float* f) {
    f[0] = bf2f(w.x & 0xffffu); f[1] = bf2f(w.x >> 16); f[2] = bf2f(w.y & 0xffffu); f[3] = bf2f(w.y >> 16);
    f[4] = bf2f(w.z & 0xffffu); f[5] = bf2f(w.z >> 16); f[6] = bf2f(w.w & 0xffffu); f[7] = bf2f(w.w >> 16);
}

__device__ __forceinline__ void phase0(const Params& P, int vb, int nb) {
    const int tid = threadIdx.x, lane = tid & 63, wave = tid >> 6;
    bf16_t* XN = (bf16_t*)(P.ws + WS_XN);
    bf16_t* WTIN = (bf16_t*)(P.ws + WS_WTIN);
    bf16_t* WTOUT = (bf16_t*)(P.ws + WS_WTOUT);
    for (int m = vb * 8 + wave; m < MA; m += nb * 8) {
        u32x2* o8 = (u32x2*)(XN + (size_t)m * DM) + lane;
        if (m >= MX + NMETA) {
#pragma unroll
            for (int j = 0; j < 4; ++j) o8[64 * j] = (u32x2){0u, 0u};
        } else {
            const float* src = (m < MX) ? P.x + (size_t)m * DM : P.meta + (size_t)(m - MX) * DM;
            const f32x4* xr = (const f32x4*)src + lane;
            f32x4 v[4]; float ss = 0.f;
#pragma unroll
            for (int j = 0; j < 4; ++j) { v[j] = xr[64 * j]; ss += (v[j].x * v[j].x + v[j].y * v[j].y) + (v[j].z * v[j].z + v[j].w * v[j].w); }
            const float rstd = 1.0f / sqrtf(wave_sum(ss) * (1.0f / DM) + EPS);
#pragma unroll
            for (int j = 0; j < 4; ++j) o8[64 * j] = (u32x2){pk2(v[j].x * rstd, v[j].y * rstd), pk2(v[j].z * rstd, v[j].w * rstd)};
        }
    }
    const int gt = vb * NTHREADS + tid, ngt = nb * NTHREADS;
    for (int id = gt; id < NPAD * (DM / 8); id += ngt) {
        const int n = id % NPAD, kc = id / NPAD;
        u32x4 w = (u32x4){0u, 0u, 0u, 0u};
        if (n < DIN) {
            float f[8];
#pragma unroll
            for (int j = 0; j < 8; ++j) f[j] = P.w_in[(size_t)(8 * kc + j) * DIN + n] * P.norm_w[8 * kc + j];
            w = (u32x4){pk2(f[0], f[1]), pk2(f[2], f[3]), pk2(f[4], f[5]), pk2(f[6], f[7])};
        }
        *(u32x4*)(WTIN + (size_t)n * DM + 8 * kc) = w;
    }
    for (int id = gt; id < DM * (2048 / 8); id += ngt) {
        const int n = id % DM, kc = id / DM;
        float f[8];
#pragma unroll
        for (int j = 0; j < 8; ++j) { const int k = 8 * kc + j; const float s = (k < 1024) ? P.sb_norm_w[k] : P.ssd_norm_w[k - 1024]; f[j] = P.w_out[(size_t)k * DM + n] * s; }
        *(u32x4*)(WTOUT + (size_t)n * 2048 + 8 * kc) = (u32x4){pk2(f[0], f[1]), pk2(f[2], f[3]), pk2(f[4], f[5]), pk2(f[6], f[7])};
    }
}

namespace pg8 {
#define PG8_LAS __attribute__((address_space(3)))
typedef unsigned short bf16_t;
typedef short bf16x8 __attribute__((ext_vector_type(8)));
typedef float f32x4 __attribute__((ext_vector_type(4)));
typedef unsigned u32x4 __attribute__((ext_vector_type(4)));
constexpr int BM = 256, BK = 64, HALF = 128, HTB = HALF * BK * 2  , STAGE_BYTES = 8 * HTB, NXCD = 8, WGM = 8;

__host__ __device__ __forceinline__ int lds_byte(int r, int c) { const int st = (r >> 4) * 2 + (c >> 5), rr = r & 15, cc = c & 31, ob = rr * 64 + cc * 2; return st * 1024 + (ob ^ (((ob >> 9) & 1) << 5)); }
__host__ __device__ __forceinline__ void stage_rc(int b, int& R, int& C) { const int st = b / 1024, sb = b % 1024, swz = sb ^ (((sb >> 9) & 1) << 5); R = (st >> 1) * 16 + swz / 64; C = (st & 1) * 32 + (swz % 64) / 2; }
__host__ __device__ __forceinline__ int perm32(int rho) { const int n = rho >> 4, i = rho & 15; return 8 * (i >> 2) + 4 * n + (i & 3); }

struct Unit { int pm, pn, sw; };
struct Gemm { const bf16_t* A; const bf16_t* Bt; int M, N, K; };

struct StaticOrder {
    int nM, nN, nwg, G, c;
    __host__ __device__ void init(int M, int N, int G_, int c_) { nM = M / BM; nN = N / BM; nwg = nM * nN; G = G_; c = c_; }
    __host__ __device__ bool next(int i, Unit& u) const {
        const long L = (long)i * G + c; if (L >= nwg) return false;
        int wgid = (int)L; { const int q = nwg / NXCD, r = nwg % NXCD, xcd = wgid % NXCD, off = wgid / NXCD; wgid = (xcd < r ? xcd * (q + 1) : r * (q + 1) + (xcd - r) * q) + off; }
        const int nig = WGM * nN, gid = wgid / nig, fm = gid * WGM, gsz = (nM - fm) < WGM ? (nM - fm) : WGM;
        u.pm = fm + ((wgid % nig) % gsz); u.pn = (wgid % nig) / gsz; u.sw = 0; return true;
    }
    __device__ __forceinline__ void a_ready(const Unit&) const {}
    __device__ __forceinline__ void done(const Unit&) const {}
};

__device__ __forceinline__ const char* unit_a(const Gemm& g, const Unit& u, size_t tstep) { return u.sw ? (const char*)g.Bt + (size_t)u.pn * tstep : (const char*)g.A + (size_t)u.pm * tstep; }
__device__ __forceinline__ const char* unit_b(const Gemm& g, const Unit& u, size_t tstep) { return u.sw ? (const char*)g.A + (size_t)u.pm * tstep : (const char*)g.Bt + (size_t)u.pn * tstep; }
template <class Epi, class Sched, bool ALIGN_EPI = false, bool SP2 = false>
__device__ __forceinline__ void gemm_phase(PG8_LAS unsigned char* lds, const Gemm g, const Sched& S, const Epi& E) {
    const int tid = threadIdx.x, wid = __builtin_amdgcn_readfirstlane(tid >> 6), lane = tid & 63, wr = wid >> 2, wc = wid & 3, fr = lane & 15, fq = lane >> 4;
    const int K = g.K, nt = K / BK;
    unsigned voffA[2], voffB[2];
#pragma unroll
    for (int i = 0; i < 2; ++i) { int R, C; stage_rc(tid * 16 + i * 8192, R, C); const int Rb = Epi::PERM ? ((R & ~31) + perm32(R & 31)) : R;
        voffA[i] = (unsigned)(R * K + C) * 2u; voffB[i] = (unsigned)(Rb * K + C) * 2u; }
    const size_t kstep = (size_t)(BK * 2);
    const size_t hstep = (size_t)HALF * K * 2;
    const size_t tstep = 2 * hstep;
    const unsigned ldsw = (unsigned)wid * 1024u;
    const int aoff = lds_byte(wr * 64 + fr, fq * 8), boff = lds_byte(wc * 32 + fr, fq * 8);
#define PG8_SA(b, h) (((b) * 2 + (h)) * HTB)
#define PG8_SB(b, h) ((4 + (b) * 2 + (h)) * HTB)
#define PG8_STAGE(bufoff, gbase, voff) do { _Pragma("unroll") for (int _i = 0; _i < 2; ++_i) \
        __builtin_amdgcn_global_load_lds((const unsigned*)((const char*)(gbase) + (voff)[_i]), (PG8_LAS unsigned*)(lds + (bufoff) + ldsw + _i * 8192), 16, 0, 0); } while (0)
#define PG8_LDA(dst, b, h) do { _Pragma("unroll") for (int m = 0; m < 4; ++m) _Pragma("unroll") for (int k = 0; k < 2; ++k) dst[m][k] = *(const PG8_LAS bf16x8*)(lds + PG8_SA(b, h) + aoff + m * 2048 + k * 1024); } while (0)
#define PG8_LDB(dst, b, h) do { _Pragma("unroll") for (int n = 0; n < 2; ++n) _Pragma("unroll") for (int k = 0; k < 2; ++k) dst[n][k] = *(const PG8_LAS bf16x8*)(lds + PG8_SB(b, h) + boff + n * 2048 + k * 1024); } while (0)
#define PG8_MMA(ai, bj, At, Bt) do { __builtin_amdgcn_s_setprio(1); _Pragma("unroll") for (int m = 0; m < 4; ++m) _Pragma("unroll") for (int n = 0; n < 2; ++n) _Pragma("unroll") for (int k = 0; k < 2; ++k) \
        acc[ai][bj][m][n] = __builtin_amdgcn_mfma_f32_16x16x32_bf16(Bt[n][k], At[m][k], acc[ai][bj][m][n], 0, 0, 0); __builtin_amdgcn_s_setprio(0); } while (0)
#define PG8_WAIT_V(n) asm volatile("s_waitcnt vmcnt(" #n ")" ::: "memory")
#define PG8_WAIT_L(n) asm volatile("s_waitcnt lgkmcnt(" #n ")" ::: "memory")
#define PG8_BAR __builtin_amdgcn_s_barrier()
#define PG8_SCHED __builtin_amdgcn_sched_barrier(0)
    Unit cur, nxt; int ui = 0;
    if (!S.next(0, cur)) return;
    f32x4 acc[2][2][4][2];
#pragma unroll
    for (int a = 0; a < 2; ++a)
#pragma unroll
        for (int b = 0; b < 2; ++b)
#pragma unroll
            for (int m = 0; m < 4; ++m)
#pragma unroll
                for (int n = 0; n < 2; ++n) acc[a][b][m][n] = (f32x4){0.f, 0.f, 0.f, 0.f};
    bf16x8 At[4][2], B0[2][2], B1[2][2];
    const char* cA = unit_a(g, cur, tstep); const char* cB = unit_b(g, cur, tstep);
    S.a_ready(cur);
    if constexpr (SP2) {
        PG8_STAGE(PG8_SB(0, 0), cB, voffB); PG8_STAGE(PG8_SB(0, 1), cB + hstep, voffB); PG8_STAGE(PG8_SA(0, 0), cA, voffA); PG8_STAGE(PG8_SA(0, 1), cA + hstep, voffA);
        if (wr == 1) PG8_BAR;
        PG8_WAIT_V(2); PG8_BAR;
        PG8_STAGE(PG8_SB(1, 0), cB + kstep, voffB); PG8_STAGE(PG8_SA(1, 0), cA + kstep, voffA); PG8_STAGE(PG8_SB(1, 1), cB + hstep + kstep, voffB);
        PG8_WAIT_V(6); PG8_BAR;
    } else {
        PG8_STAGE(PG8_SB(0, 0), cB, voffB); PG8_STAGE(PG8_SA(0, 0), cA, voffA); PG8_STAGE(PG8_SB(0, 1), cB + hstep, voffB); PG8_STAGE(PG8_SA(0, 1), cA + hstep, voffA);
        if (wr == 1) PG8_BAR;
        PG8_WAIT_V(4); PG8_BAR;
        PG8_STAGE(PG8_SB(1, 0), cB + kstep, voffB); PG8_STAGE(PG8_SA(1, 0), cA + kstep, voffA); PG8_STAGE(PG8_SB(1, 1), cB + hstep + kstep, voffB);
        PG8_WAIT_V(6); PG8_BAR;
    }
    for (;;) {
        const bool has_next = S.next(ui + 1, nxt);
        const char* nA = has_next ? unit_a(g, nxt, tstep) : cA; const char* nB = has_next ? unit_b(g, nxt, tstep) : cB;
        for (int t = 0; t < nt; t += 2) {
            const bool last = (t == nt - 2);
            const char* a1 = cA + (size_t)(t + 1) * kstep;
            const char* a2 = last ? nA : cA + (size_t)(t + 2) * kstep; const char* b2 = last ? nB : cB + (size_t)(t + 2) * kstep;
            const char* a3 = a2 + kstep; const char* b3 = b2 + kstep;
            if (last && has_next) S.a_ready(nxt);
            if constexpr (Epi::HAS_MID) { if (t == nt / 2) E.mid(acc, wr, fr); }
            if constexpr (SP2) {
            PG8_LDB(B0, 0, 0); PG8_LDB(B1, 0, 1); PG8_SCHED; PG8_LDA(At, 0, 0); PG8_STAGE(PG8_SA(1, 1), a1 + hstep, voffA);
            PG8_WAIT_V(8); PG8_WAIT_L(0); PG8_BAR; PG8_MMA(0, 0, At, B0); PG8_MMA(0, 1, At, B1); PG8_BAR; PG8_SCHED;
            PG8_LDA(At, 0, 1); PG8_STAGE(PG8_SB(0, 0), b2, voffB); PG8_STAGE(PG8_SB(0, 1), b2 + hstep, voffB); PG8_STAGE(PG8_SA(0, 0), a2, voffA);
            PG8_WAIT_V(8); PG8_WAIT_L(0); PG8_BAR; PG8_MMA(1, 0, At, B0); PG8_MMA(1, 1, At, B1); PG8_BAR; PG8_SCHED;
            PG8_LDB(B0, 1, 0); PG8_LDB(B1, 1, 1); PG8_SCHED; PG8_LDA(At, 1, 0); PG8_STAGE(PG8_SA(0, 1), a2 + hstep, voffA);
            PG8_WAIT_V(8); PG8_WAIT_L(0); PG8_BAR; PG8_MMA(0, 0, At, B0); PG8_MMA(0, 1, At, B1); PG8_BAR; PG8_SCHED;
            PG8_LDA(At, 1, 1); PG8_STAGE(PG8_SB(1, 0), b3, voffB); PG8_STAGE(PG8_SB(1, 1), b3 + hstep, voffB); PG8_STAGE(PG8_SA(1, 0), a3, voffA);
            PG8_WAIT_V(8); PG8_WAIT_L(0); PG8_BAR; PG8_MMA(1, 0, At, B0); PG8_MMA(1, 1, At, B1); PG8_BAR; PG8_SCHED;
            } else {
            PG8_LDB(B0, 0, 0); PG8_SCHED; PG8_LDA(At, 0, 0); PG8_STAGE(PG8_SA(1, 1), a1 + hstep, voffA);
            PG8_WAIT_L(8); PG8_BAR; PG8_WAIT_L(0); PG8_MMA(0, 0, At, B0); PG8_BAR; PG8_SCHED;
            PG8_LDB(B1, 0, 1); PG8_STAGE(PG8_SB(0, 0), b2, voffB);
            PG8_BAR; PG8_WAIT_L(0); PG8_MMA(0, 1, At, B1); PG8_BAR;
            PG8_LDA(At, 0, 1); PG8_STAGE(PG8_SA(0, 0), a2, voffA);
            PG8_BAR; PG8_WAIT_L(0); PG8_MMA(1, 0, At, B0); PG8_BAR; PG8_SCHED;
            PG8_STAGE(PG8_SB(0, 1), b2 + hstep, voffB);
            PG8_WAIT_V(6); PG8_BAR; PG8_MMA(1, 1, At, B1); PG8_BAR;
            PG8_LDB(B0, 1, 0); PG8_SCHED; PG8_LDA(At, 1, 0); PG8_STAGE(PG8_SA(0, 1), a2 + hstep, voffA);
            PG8_WAIT_L(8); PG8_BAR; PG8_WAIT_L(0); PG8_MMA(0, 0, At, B0); PG8_BAR; PG8_SCHED;
            PG8_LDB(B1, 1, 1); PG8_STAGE(PG8_SB(1, 0), b3, voffB);
            PG8_BAR; PG8_WAIT_L(0); PG8_MMA(0, 1, At, B1); PG8_BAR;
            PG8_LDA(At, 1, 1); PG8_STAGE(PG8_SA(1, 0), a3, voffA);
            PG8_BAR; PG8_WAIT_L(0); PG8_MMA(1, 0, At, B0); PG8_BAR; PG8_SCHED;
            PG8_STAGE(PG8_SB(1, 1), b3 + hstep, voffB);
            PG8_WAIT_V(6); PG8_BAR; PG8_MMA(1, 1, At, B1); PG8_BAR;
            }
        }
        if constexpr (ALIGN_EPI) { if (wr == 0) PG8_BAR; }
        if constexpr (!Epi::AFTER_DRAIN) { E(acc, cur, wr, wc, fr, fq); S.done(cur); }
        if (!has_next) break;
#pragma unroll
        for (int a = 0; a < 2; ++a)
#pragma unroll
            for (int b = 0; b < 2; ++b)
#pragma unroll
                for (int m = 0; m < 4; ++m)
#pragma unroll
                    for (int n = 0; n < 2; ++n) acc[a][b][m][n] = (f32x4){0.f, 0.f, 0.f, 0.f};
        cur = nxt; cA = nA; cB = nB; ++ui;
        if constexpr (ALIGN_EPI) { if (wr == 1) PG8_BAR; }
    }
    PG8_WAIT_V(0);
    if constexpr (!ALIGN_EPI) { if (wr == 0) PG8_BAR; }
    PG8_BAR;
    if constexpr (Epi::AFTER_DRAIN) { E.fused(acc, cur, wr, wc, fr, fq, lds, wid, lane); S.done(cur); }
#undef PG8_SA
#undef PG8_SB
#undef PG8_STAGE
#undef PG8_LDA
#undef PG8_LDB
#undef PG8_MMA
#undef PG8_WAIT_V
#undef PG8_WAIT_L
#undef PG8_BAR
#undef PG8_SCHED
}
}

__device__ __forceinline__ unsigned cvt_pk_bf16(float lo, float hi) { unsigned r; asm volatile("v_cvt_pk_bf16_f32 %0, %1, %2" : "=v"(r) : "v"(lo), "v"(hi)); return r; }
__device__ __forceinline__ u32x4 pack8(const f32x4 v0, const f32x4 v1) { u32x4 w; w.x = cvt_pk_bf16(v0[0], v0[1]); w.y = cvt_pk_bf16(v0[2], v0[3]); w.z = cvt_pk_bf16(v1[0], v1[1]); w.w = cvt_pk_bf16(v1[2], v1[3]); return w; }
__device__ __forceinline__ f32x4 silu4(const f32x4 v) { f32x4 o;
#pragma unroll
    for (int j = 0; j < 4; ++j) o[j] = v[j] * __builtin_amdgcn_rcpf(1.0f + __expf(-v[j]));
    return o; }

struct Order1 {
    int G, c;
    __device__ __forceinline__ bool next(int i, pg8::Unit& u) const {
        constexpr int nM = 64, nN = 27, nwg = nM * nN;
        const int L = i * G + c;
        if (L < nwg) { const int xcd = L % 8, off = L / 8, wgid = xcd * (nwg / 8) + off; const int nig = 8 * nN, gid = wgid / nig, fm = gid * 8;
            u.pm = fm + ((wgid % nig) % 8); u.pn = (wgid % nig) / 8; u.sw = (u.pn >= 8 && u.pn < 12) ? 1 : 0; return true; }
        const int j = L - nwg; if (j >= 15) return false;
        u.pm = 64; u.pn = j < 8 ? 4 + j : 12 + j; u.sw = (u.pn >= 8 && u.pn < 12) ? 1 : 0; return true;
    }
    __device__ __forceinline__ void a_ready(const pg8::Unit&) const {}
    __device__ __forceinline__ void done(const pg8::Unit&) const {}
};

struct Epi1M {
    static constexpr bool PERM = true, AFTER_DRAIN = false, HAS_MID = false;
    bf16_t *Q, *KB, *VT, *GZ, *XBC; float* DT; const float* dt_bias;
    __device__ __forceinline__ void mid(f32x4 (&)[2][2][4][2], int, int) const {}
    __device__ __forceinline__ void operator()(const f32x4 (&acc)[2][2][4][2], const pg8::Unit& u, int wr, int wc, int fr, int fq) const {
        const int pn = u.pn, pm = u.pm;
        asm volatile("" : "+v"(fr), "+v"(fq));
        const int rl0 = wr * 64 + fr, cl0 = wc * 32 + 8 * fq;
        if (u.sw) {
            const int vc0 = (pn - 8) * 256 + rl0;
            if (pm < 64) {
                const int b = pm >> 3, i0 = (pm & 7) * 256 + cl0;
#pragma unroll
                for (int ai = 0; ai < 2; ++ai)
#pragma unroll
                    for (int m = 0; m < 4; ++m) { bf16_t* rowp = VT + ((size_t)(b * 1024 + vc0 + ai * 128 + m * 16)) * LT + NMETA + i0;
#pragma unroll
                        for (int bj = 0; bj < 2; ++bj) *(u32x4*)(rowp + bj * 128) = pack8(acc[ai][bj][m][0], acc[ai][bj][m][1]); }
            } else if (wc == 0 && fq < 2) {
#pragma unroll
                for (int ai = 0; ai < 2; ++ai)
#pragma unroll
                    for (int m = 0; m < 4; ++m) { const u32x4 w = pack8(acc[ai][0][m][0], acc[ai][0][m][1]);
                        _Pragma("unroll 1") for (int b = 0; b < NB; ++b) *(u32x4*)(VT + ((size_t)(b * 1024 + vc0 + ai * 128 + m * 16)) * LT + 8 * fq) = w; }
            }
            return;
        }
        if (pm < 64) {
            const int b = pm >> 3;
            if (pn < 4) {
#pragma unroll
                for (int ai = 0; ai < 2; ++ai)
#pragma unroll
                    for (int m = 0; m < 4; ++m) { bf16_t* rowp = Q + (size_t)(pm * 256 + rl0 + ai * 128 + m * 16) * 1024 + pn * 256 + cl0;
#pragma unroll
                        for (int bj = 0; bj < 2; ++bj) *(u32x4*)(rowp + bj * 128) = pack8(acc[ai][bj][m][0] * 0.125f, acc[ai][bj][m][1] * 0.125f); }
            } else if (pn < 8) {
#pragma unroll
                for (int ai = 0; ai < 2; ++ai)
#pragma unroll
                    for (int m = 0; m < 4; ++m) { bf16_t* rowp = KB + (size_t)(pm * 256 + rl0 + ai * 128 + m * 16 + NMETA * (b + 1)) * 1024 + (pn - 4) * 256 + cl0;
#pragma unroll
                        for (int bj = 0; bj < 2; ++bj) *(u32x4*)(rowp + bj * 128) = pack8(acc[ai][bj][m][0], acc[ai][bj][m][1]); }
            } else if (pn < 20) {
#pragma unroll
                for (int ai = 0; ai < 2; ++ai)
#pragma unroll
                    for (int m = 0; m < 4; ++m) { bf16_t* rowp = GZ + (size_t)(pm * 256 + rl0 + ai * 128 + m * 16) * 2048 + (pn - 12) * 256 + cl0;
#pragma unroll
                        for (int bj = 0; bj < 2; ++bj) *(u32x4*)(rowp + bj * 128) = pack8(silu4(acc[ai][bj][m][0]), silu4(acc[ai][bj][m][1])); }
            } else if (pn < 26) {
#pragma unroll
                for (int ai = 0; ai < 2; ++ai)
#pragma unroll
                    for (int m = 0; m < 4; ++m) { bf16_t* rowp = XBC + (size_t)(pm * 256 + rl0 + ai * 128 + m * 16 + NMETA * (b + 1)) * XBCW + (pn - 20) * 256 + cl0;
#pragma unroll
                        for (int bj = 0; bj < 2; ++bj) *(u32x4*)(rowp + bj * 128) = pack8(acc[ai][bj][m][0], acc[ai][bj][m][1]); }
            } else if (wc == 0 && fq < 2) {
                const f32x4 b0 = *(const f32x4*)(dt_bias + 8 * fq), b1 = *(const f32x4*)(dt_bias + 8 * fq + 4);
#pragma unroll
                for (int ai = 0; ai < 2; ++ai)
#pragma unroll
                    for (int m = 0; m < 4; ++m) { float* rowp = DT + (size_t)(pm * 256 + rl0 + ai * 128 + m * 16 + NMETA * (b + 1)) * 16 + 8 * fq;
                        f32x4 o0, o1;
#pragma unroll
                        for (int j = 0; j < 4; ++j) { o0[j] = softplus_f(acc[ai][0][m][0][j] + b0[j]); o1[j] = softplus_f(acc[ai][0][m][1][j] + b1[j]); }
                        *(f32x4*)rowp = o0; *(f32x4*)(rowp + 4) = o1; }
            }
            return;
        }
        if (wr != 0) return;
        if (pn < 8) {
            _Pragma("unroll 1") for (int b = 0; b < NB; ++b) { bf16_t* rowp = KB + (size_t)(b * LT + fr) * 1024 + (pn - 4) * 256 + cl0;
#pragma unroll
                for (int bj = 0; bj < 2; ++bj) *(u32x4*)(rowp + bj * 128) = pack8(acc[0][bj][0][0], acc[0][bj][0][1]); }
        } else if (pn < 26) {
            _Pragma("unroll 1") for (int b = 0; b < NB; ++b) { bf16_t* rowp = XBC + (size_t)(b * LT + fr) * XBCW + (pn - 20) * 256 + cl0;
#pragma unroll
                for (int bj = 0; bj < 2; ++bj) *(u32x4*)(rowp + bj * 128) = pack8(acc[0][bj][0][0], acc[0][bj][0][1]); }
        } else if (wc == 0 && fq < 2) {
            const f32x4 b0 = *(const f32x4*)(dt_bias + 8 * fq), b1 = *(const f32x4*)(dt_bias + 8 * fq + 4);
            f32x4 o0, o1;
#pragma unroll
            for (int j = 0; j < 4; ++j) { o0[j] = softplus_f(acc[0][0][0][0][j] + b0[j]); o1[j] = softplus_f(acc[0][0][0][1][j] + b1[j]); }
            _Pragma("unroll 1") for (int b = 0; b < NB; ++b) { float* rowp = DT + (size_t)(b * LT + fr) * 16 + 8 * fq; *(f32x4*)rowp = o0; *(f32x4*)(rowp + 4) = o1; }
        }
    }
};

__device__ __forceinline__ void row_rstd(const float* SSQ, int m, float& rs_sb, float& rs_ssd) {
    const f32x4* p = (const f32x4*)(SSQ + (size_t)m * 64);
    float s1 = 0.f, s2 = 0.f;
#pragma unroll
    for (int j = 0; j < 4; ++j) { const f32x4 a = p[j]; s1 += (a.x + a.y) + (a.z + a.w); }
#pragma unroll
    for (int j = 4; j < 12; ++j) { const f32x4 a = p[j]; s2 += (a.x + a.y) + (a.z + a.w); }
    rs_sb = 1.0f / sqrtf(s1 * (1.0f / 1024.0f) + EPS); rs_ssd = 1.0f / sqrtf(s2 * (1.0f / 1024.0f) + EPS);
}

struct Epi2M {
    static constexpr bool PERM = false, AFTER_DRAIN = false, HAS_MID = true;
    const float* x; float* out; const PG8_LAS float* RS;
    __device__ __forceinline__ void mid(f32x4 (&acc)[2][2][4][2], int wr, int fr) const {
#pragma unroll
        for (int ai = 0; ai < 2; ++ai)
#pragma unroll
            for (int m = 0; m < 4; ++m) { const float r = RS[2 * (ai * 128 + wr * 64 + m * 16 + fr)];
#pragma unroll
                for (int bj = 0; bj < 2; ++bj)
#pragma unroll
                    for (int n = 0; n < 2; ++n) acc[ai][bj][m][n] *= r; }
    }
    __device__ __forceinline__ void operator()(const f32x4 (&acc)[2][2][4][2], const pg8::Unit& u, int wr, int wc, int fr, int fq) const {
        const int col0 = u.pn * 256 + wc * 32 + 4 * fq;
#pragma unroll
        for (int ai = 0; ai < 2; ++ai)
#pragma unroll
            for (int m = 0; m < 4; ++m) { const int r = ai * 128 + wr * 64 + m * 16 + fr; const float rs = RS[2 * r + 1]; const size_t off = (size_t)(u.pm * 256 + r) * DM + col0;
#pragma unroll
                for (int bj = 0; bj < 2; ++bj)
#pragma unroll
                    for (int n = 0; n < 2; ++n) { const f32x4 xv = *(const f32x4*)(x + off + bj * 128 + n * 16); *(f32x4*)(out + off + bj * 128 + n * 16) = xv + acc[ai][bj][m][n] * rs; } }
    }
};

typedef short bf16x8 __attribute__((ext_vector_type(8)));
typedef short s16x4 __attribute__((ext_vector_type(4)));
typedef float f32x16 __attribute__((ext_vector_type(16)));
#ifndef ATT_THR2
#define ATT_THR2 150.0f
#endif
#ifndef ATT_EARLY
#define ATT_EARLY 1
#endif
__device__ __forceinline__ void attn_mfma(const Params& P, int gw, int ngw) {
    const bf16_t* Q = (const bf16_t*)P.out;
    const bf16_t* KB = (const bf16_t*)(P.ws + WS_KB);
    const bf16_t* VT = (const bf16_t*)(P.ws + WS_VT);
    bf16_t* GZ = (bf16_t*)(P.ws + WS_GZ);
    float* SSQ = (float*)(P.ws + WS_SSQ);
    const int lane = threadIdx.x & 63, r32 = lane & 31, hh = lane >> 5;
    constexpr float L2E = 1.4426950408889634f;
    for (int item = gw; item < NB * 16 * 64; item += ngw) {
        const int rnd = item / ngw, qraw = item & 63, qblk = (rnd & 1) ? 63 - qraw : qraw, h = (item >> 6) & 15, b = item >> 10;
        const int tq = NMETA + 32 * qblk + r32;
        const size_t m = (size_t)b * SEQ + 32 * qblk + r32;
        bf16x8 qf[4];
#pragma unroll
        for (int ks = 0; ks < 4; ++ks) qf[ks] = *(const bf16x8*)(Q + m * 1024 + h * 64 + 16 * ks + 8 * hh);
        f32x16 o0, o1;
#pragma unroll
        for (int i = 0; i < 16; ++i) { o0[i] = 0.f; o1[i] = 0.f; }
        float carry = 0.f;
        const bf16_t* Kh = KB + (size_t)b * LT * 1024 + h * 64 + 8 * hh;
        const bf16_t* Vh = VT + ((size_t)b * 1024 + h * 64 + r32) * LT;
        for (int kt = qblk + 1; kt >= 0; --kt) {
            const int s0 = 32 * kt;
            int krow = s0 + r32; krow = krow < LT ? krow : LT - 1;
            bf16x8 kf[4];
#pragma unroll
            for (int ks = 0; ks < 4; ++ks) kf[ks] = *(const bf16x8*)(Kh + (size_t)krow * 1024 + 16 * ks);
            s16x4 vlo[2][2], vhi[2][2];
#pragma unroll
            for (int s = 0; s < 2; ++s) {
                int k0 = s0 + 16 * s + 4 * hh, k1 = k0 + 8;
                k0 = k0 < LT ? k0 : LT - 4; k1 = k1 < LT ? k1 : LT - 4;
#pragma unroll
                for (int db = 0; db < 2; ++db) { vlo[db][s] = *(const s16x4*)(Vh + (size_t)db * 32 * LT + k0); vhi[db][s] = *(const s16x4*)(Vh + (size_t)db * 32 * LT + k1); }
            }
            f32x16 st;
#pragma unroll
            for (int i = 0; i < 16; ++i) st[i] = 0.f;
#pragma unroll
            for (int ks = 0; ks < 4; ++ks) st = __builtin_amdgcn_mfma_f32_32x32x16_bf16(kf[ks], qf[ks], st, 0, 0, 0);
            float ls[16], z2[16];
#pragma unroll
            for (int i = 0; i < 16; ++i) {
                z2[i] = st[i] * L2E;
                const float e = __builtin_amdgcn_exp2f(-__builtin_fabsf(z2[i]));
                ls[i] = -(__builtin_fmaxf(z2[i], 0.f) + __builtin_amdgcn_logf(1.0f + e));
            }
            const bool masked = kt >= qblk;
            if (masked) {
#pragma unroll
                for (int i = 0; i < 16; ++i) { const int key = s0 + (i & 3) + 8 * (i >> 2) + 4 * hh; if (key >= tq) ls[i] = 0.f; }
            }
            float T[4], To[4];
#pragma unroll
            for (int g = 0; g < 4; ++g) { ls[4 * g + 2] += ls[4 * g + 3]; ls[4 * g + 1] += ls[4 * g + 2]; ls[4 * g] += ls[4 * g + 1]; T[g] = ls[4 * g]; }
#pragma unroll
            for (int g = 0; g < 4; ++g) To[g] = __shfl_xor(T[g], 32);
            const float P0 = T[0] + To[0], P1 = T[1] + To[1], P2 = T[2] + To[2], P3 = T[3] + To[3];
            float off[4];
            off[3] = carry; off[2] = off[3] + P3; off[1] = off[2] + P2; off[0] = off[1] + P1;
            carry = off[0] + P0;
            if (hh == 0) {
#pragma unroll
                for (int g = 0; g < 4; ++g) off[g] += To[g];
            }
            float w[16];
#pragma unroll
            for (int i = 0; i < 16; ++i) w[i] = __builtin_amdgcn_exp2f(z2[i] + ls[i] + off[i >> 2]);
            if (masked) {
#pragma unroll
                for (int i = 0; i < 16; ++i) { const int key = s0 + (i & 3) + 8 * (i >> 2) + 4 * hh; if (key >= tq) w[i] = 0.f; }
            }
            bf16x8 wf[2];
#pragma unroll
            for (int s = 0; s < 2; ++s) {
                const unsigned a0 = cvtpk(w[8 * s], w[8 * s + 1]), a1 = cvtpk(w[8 * s + 2], w[8 * s + 3]), a2 = cvtpk(w[8 * s + 4], w[8 * s + 5]), a3 = cvtpk(w[8 * s + 6], w[8 * s + 7]);
                const u32x4 pk = (u32x4){a0, a1, a2, a3};
                wf[s] = __builtin_bit_cast(bf16x8, pk);
            }
#pragma unroll
            for (int s = 0; s < 2; ++s) {
                const bf16x8 va0 = (bf16x8){vlo[0][s][0], vlo[0][s][1], vlo[0][s][2], vlo[0][s][3], vhi[0][s][0], vhi[0][s][1], vhi[0][s][2], vhi[0][s][3]};
                const bf16x8 va1 = (bf16x8){vlo[1][s][0], vlo[1][s][1], vlo[1][s][2], vlo[1][s][3], vhi[1][s][0], vhi[1][s][1], vhi[1][s][2], vhi[1][s][3]};
                o0 = __builtin_amdgcn_mfma_f32_32x32x16_bf16(va0, wf[s], o0, 0, 0, 0);
                o1 = __builtin_amdgcn_mfma_f32_32x32x16_bf16(va1, wf[s], o1, 0, 0, 0);
            }
#if ATT_EARLY
            if (__all(carry < -ATT_THR2)) break;
#endif
        }
        float ss = 0.f;
#pragma unroll
        for (int db = 0; db < 2; ++db)
#pragma unroll
            for (int g = 0; g < 4; ++g) {
                u32x2* gp = (u32x2*)(GZ + m * 2048 + h * 64 + 32 * db + 8 * g + 4 * hh);
                const u32x2 gv = *gp;
                const float g0 = bf2f(gv.x & 0xffffu), g1 = bf2f(gv.x >> 16), g2 = bf2f(gv.y & 0xffffu), g3 = bf2f(gv.y >> 16);
                const float y0 = (db ? o1[4 * g] : o0[4 * g]) * g0, y1 = (db ? o1[4 * g + 1] : o0[4 * g + 1]) * g1, y2 = (db ? o1[4 * g + 2] : o0[4 * g + 2]) * g2, y3 = (db ? o1[4 * g + 3] : o0[4 * g + 3]) * g3;
                ss += (y0 * y0 + y1 * y1) + (y2 * y2 + y3 * y3);
                *gp = (u32x2){cvtpk(y0, y1), cvtpk(y2, y3)};
            }
        ss += __shfl_xor(ss, 32);
        if (hh == 0) SSQ[m * 64 + h] = ss;
    }
}

__device__ __forceinline__ void conv_phase(const Params& P, int vb, int nb) {
    const bf16_t* XBC = (const bf16_t*)(P.ws + WS_XBC);
    const float* DT = (const float*)(P.ws + WS_DT);
    bf16_t* XT = (bf16_t*)(P.ws + WS_XT); bf16_t* XC = (bf16_t*)(P.ws + WS_XC);
    bf16_t* BC = (bf16_t*)((unsigned char*)P.out + DO_BC); bf16_t* BT = (bf16_t*)((unsigned char*)P.out + DO_BT); float* DTP = (float*)((unsigned char*)P.out + DO_DTP);
    const int gt = vb * NTHREADS + threadIdx.x, ngt = nb * NTHREADS;
    const u32x4 zero4 = (u32x4){0u, 0u, 0u, 0u};
    for (int id = gt; id < NB * 48 * 128; id += ngt) { const int c = id & 127, r = id >> 7, pp = r % 48, b = r / 48; *(u32x4*)(XC + ((size_t)b * LP + pp) * 1024 + 8 * c) = zero4; }
    for (int id = gt; id < NB * 48 * 64; id += ngt) { const int c = id & 63, r = id >> 6, pp = r % 48, b = r / 48; *(u32x4*)(BC + ((size_t)b * LP + pp) * 512 + 8 * c) = zero4; }
    for (int id = gt; id < NB * 1024 * 6; id += ngt) { const int j = id % 6, row = id / 6; *(u32x4*)(XT + (size_t)row * LP + 8 * j) = zero4; }
    for (int id = gt; id < NB * 256 * 6; id += ngt) { const int j = id % 6, row = id / 6; *(u32x4*)(BT + (size_t)row * LP + 8 * j) = zero4; }
    for (int id = gt; id < NB * LP * 4; id += ngt) { const int q = id & 3, r = id >> 2, pp = r % LP, b = r / LP;
        f32x4 v = (f32x4){0.f, 0.f, 0.f, 0.f}; if (pp >= 48) v = *(const f32x4*)(DT + ((size_t)b * LT + (pp - 48)) * 16 + 4 * q);
        *(f32x4*)(DTP + ((size_t)b * LP + pp) * 16 + 4 * q) = v; }
    for (int id = gt; id < NB * 258 * 192; id += ngt) {
        const int cg = id % 192, r = id / 192, tb = r % 258, b = r / 258, tok0 = 8 * tb, c0 = 8 * cg;
        float wj[4][8], bias[8];
#pragma unroll
        for (int j = 0; j < 4; ++j) { const f32x4 w0 = *(const f32x4*)(P.conv_w + j * XBCW + c0), w1 = *(const f32x4*)(P.conv_w + j * XBCW + c0 + 4);
            wj[j][0] = w0.x; wj[j][1] = w0.y; wj[j][2] = w0.z; wj[j][3] = w0.w; wj[j][4] = w1.x; wj[j][5] = w1.y; wj[j][6] = w1.z; wj[j][7] = w1.w; }
        { const f32x4 b0 = *(const f32x4*)(P.conv_b + c0), b1 = *(const f32x4*)(P.conv_b + c0 + 4); bias[0] = b0.x; bias[1] = b0.y; bias[2] = b0.z; bias[3] = b0.w; bias[4] = b1.x; bias[5] = b1.y; bias[6] = b1.z; bias[7] = b1.w; }
        float raw[11][8];
#pragma unroll
        for (int rr = 0; rr < 11; ++rr) { const int tok = tok0 - 3 + rr; u32x4 w = zero4; if (tok >= 0) w = *(const u32x4*)(XBC + ((size_t)b * LT + tok) * XBCW + c0); unpack8(w, raw[rr]); }
        unsigned tw[8][4];
        bf16_t* rowdst = (cg < 128) ? XC + ((size_t)b * LP + 48 + tok0) * 1024 + c0 : BC + ((size_t)b * LP + 48 + tok0) * 512 + (c0 - 1024);
        const int rowpitch = (cg < 128) ? 1024 : 512;
#pragma unroll
        for (int tp = 0; tp < 4; ++tp) {
            float o0[8], o1[8];
#pragma unroll
            for (int cc = 0; cc < 8; ++cc) {
                float v0 = bias[cc], v1 = bias[cc];
#pragma unroll
                for (int j = 0; j < 4; ++j) { v0 += wj[j][cc] * raw[2 * tp + j][cc]; v1 += wj[j][cc] * raw[2 * tp + 1 + j][cc]; }
                o0[cc] = silu_f(v0); o1[cc] = silu_f(v1); tw[cc][tp] = pk2(o0[cc], o1[cc]);
            }
            *(u32x4*)(rowdst + (size_t)(2 * tp) * rowpitch) = (u32x4){pk2(o0[0], o0[1]), pk2(o0[2], o0[3]), pk2(o0[4], o0[5]), pk2(o0[6], o0[7])};
            *(u32x4*)(rowdst + (size_t)(2 * tp + 1) * rowpitch) = (u32x4){pk2(o1[0], o1[1]), pk2(o1[2], o1[3]), pk2(o1[4], o1[5]), pk2(o1[6], o1[7])};
        }
        if (cg < 160) {
            bf16_t* tdst = (cg < 128) ? XT + ((size_t)b * 1024 + c0) * LP + 48 + tok0 : BT + ((size_t)b * 256 + (c0 - 1024)) * LP + 48 + tok0;
#pragma unroll
            for (int cc = 0; cc < 8; ++cc) *(u32x4*)(tdst + (size_t)cc * LP) = (u32x4){tw[cc][0], tw[cc][1], tw[cc][2], tw[cc][3]};
        }
    }
}

__device__ __forceinline__ bf16x8 pack_bf8(const float* v) { const u32x4 pk = (u32x4){cvtpk(v[0], v[1]), cvtpk(v[2], v[3]), cvtpk(v[4], v[5]), cvtpk(v[6], v[7])}; return __builtin_bit_cast(bf16x8, pk); }
__device__ __forceinline__ bf16x8 load_2x4(const bf16_t* p) { const s16x4 lo = *(const s16x4*)p, hi = *(const s16x4*)(p + 8); return (bf16x8){lo[0], lo[1], lo[2], lo[3], hi[0], hi[1], hi[2], hi[3]}; }
__device__ __forceinline__ void ssd_wave(const Params& P, PG8_LAS float* ldsw, int unit) {
    const bf16_t* XT = (const bf16_t*)(P.ws + WS_XT); const bf16_t* XC = (const bf16_t*)(P.ws + WS_XC);
    const bf16_t* BC = (const bf16_t*)((const unsigned char*)P.out + DO_BC); const bf16_t* BT = (const bf16_t*)((const unsigned char*)P.out + DO_BT); const float* DTP = (const float*)((const unsigned char*)P.out + DO_DTP);
    bf16_t* GZ = (bf16_t*)(P.ws + WS_GZ); float* SSQ = (float*)(P.ws + WS_SSQ);
    const int lane = threadIdx.x & 63, r32 = lane & 31, hh = lane >> 5;
    const int ph = unit & 1, hd = (unit >> 1) & 15, b = unit >> 5, g = hd >> 3;
    const float a = -__expf(P.a_log[hd]), Dk = P.d_skip[hd];
    f32x16 hT[4];
#pragma unroll
    for (int nbk = 0; nbk < 4; ++nbk)
#pragma unroll
        for (int i = 0; i < 16; ++i) hT[nbk][i] = 0.f;
    const bf16_t* BCb = BC + (size_t)b * LP * 512 + g * 128 + 4 * hh;
    const bf16_t* XTr = XT + ((size_t)b * 1024 + hd * 64 + 32 * ph + r32) * LP + 4 * hh;
    const bf16_t* BTr = BT + ((size_t)b * 256 + g * 128 + r32) * LP + 4 * hh;
    for (int c = 0; c < 33; ++c) {
        const int pp0 = 64 * c;
        const float dtl = DTP[((size_t)b * LP + pp0 + lane) * 16 + hd];
        float ac = dtl * a;
#pragma unroll
        for (int o = 1; o < 64; o <<= 1) { const float t = __shfl_up(ac, o); if (lane >= o) ac += t; }
        const float atot = __shfl(ac, 63);
        ldsw[lane] = ac; ldsw[64 + lane] = dtl; ldsw[128 + lane] = dtl * __expf(atot - ac);
        bf16x8 xtf[4];
#pragma unroll
        for (int t = 0; t < 4; ++t) xtf[t] = load_2x4(XTr + pp0 + 16 * t);
#pragma unroll
        for (int lb = 0; lb < 2; ++lb) {
            const int lrow = pp0 + 32 * lb + r32;
            asm volatile("" ::: "memory");
            f32x16 y, st0, st1;
#pragma unroll
            for (int i = 0; i < 16; ++i) { y[i] = 0.f; st0[i] = 0.f; st1[i] = 0.f; }
#pragma unroll
            for (int ks = 0; ks < 8; ++ks) {
                const bf16x8 cmf = load_2x4(BCb + (size_t)lrow * 512 + 256 + 16 * ks);
                float v[8];
#pragma unroll
                for (int j = 0; j < 8; ++j) v[j] = hT[ks >> 1][8 * (ks & 1) + j];
                y = __builtin_amdgcn_mfma_f32_32x32x16_bf16(pack_bf8(v), cmf, y, 0, 0, 0);
                st0 = __builtin_amdgcn_mfma_f32_32x32x16_bf16(load_2x4(BCb + (size_t)(pp0 + r32) * 512 + 16 * ks), cmf, st0, 0, 0, 0);
                if (lb == 1) st1 = __builtin_amdgcn_mfma_f32_32x32x16_bf16(load_2x4(BCb + (size_t)(pp0 + 32 + r32) * 512 + 16 * ks), cmf, st1, 0, 0, 0);
            }
            const float acl = ldsw[32 * lb + r32], el = __expf(acl);
#pragma unroll
            for (int i = 0; i < 16; ++i) y[i] *= el;
#pragma unroll
            for (int sb = 0; sb <= lb; ++sb) {
                float lt[16];
#pragma unroll
                for (int gq = 0; gq < 4; ++gq) {
                    const f32x4 acs = *(const PG8_LAS f32x4*)(ldsw + 32 * sb + 8 * gq + 4 * hh), dts = *(const PG8_LAS f32x4*)(ldsw + 64 + 32 * sb + 8 * gq + 4 * hh);
#pragma unroll
                    for (int j = 0; j < 4; ++j) { float mm = __expf(acl - acs[j]) * dts[j]; if (sb == lb && (8 * gq + 4 * hh + j) > r32) mm = 0.f; lt[4 * gq + j] = (sb == 0 ? st0[4 * gq + j] : st1[4 * gq + j]) * mm; }
                }
#pragma unroll
                for (int t = 0; t < 2; ++t) y = __builtin_amdgcn_mfma_f32_32x32x16_bf16(xtf[2 * sb + t], pack_bf8(lt + 8 * t), y, 0, 0, 0);
            }
            asm volatile("" ::: "memory");
            if (c >= 1) {
                const size_t m = (size_t)b * SEQ + 64 * (c - 1) + 32 * lb + r32;
                float ss = 0.f;
#pragma unroll
                for (int gq = 0; gq < 4; ++gq) {
                    const int p4 = hd * 64 + 32 * ph + 8 * gq + 4 * hh;
                    const u32x2 xv = *(const u32x2*)(XC + ((size_t)b * LP + lrow) * 1024 + p4);
                    u32x2* gp = (u32x2*)(GZ + m * 2048 + 1024 + p4);
                    const u32x2 gv = *gp;
                    const float y0 = (y[4 * gq] + Dk * bf2f(xv.x & 0xffffu)) * bf2f(gv.x & 0xffffu), y1 = (y[4 * gq + 1] + Dk * bf2f(xv.x >> 16)) * bf2f(gv.x >> 16);
                    const float y2 = (y[4 * gq + 2] + Dk * bf2f(xv.y & 0xffffu)) * bf2f(gv.y & 0xffffu), y3 = (y[4 * gq + 3] + Dk * bf2f(xv.y >> 16)) * bf2f(gv.y >> 16);
                    ss += (y0 * y0 + y1 * y1) + (y2 * y2 + y3 * y3);
                    *gp = (u32x2){cvtpk(y0, y1), cvtpk(y2, y3)};
                }
                ss += __shfl_xor(ss, 32);
                if (hh == 0) SSQ[m * 64 + 16 + 2 * hd + ph] = ss;
            }
        }
        asm volatile("" ::: "memory");
        const float dec = __expf(atot);
        bf16x8 xs[4];
#pragma unroll
        for (int t = 0; t < 4; ++t) {
            const f32x4 s0 = *(const PG8_LAS f32x4*)(ldsw + 128 + 16 * t + 4 * hh), s1 = *(const PG8_LAS f32x4*)(ldsw + 128 + 16 * t + 4 * hh + 8);
            float v[8];
#pragma unroll
            for (int j = 0; j < 4; ++j) { v[j] = bf2f((unsigned short)xtf[t][j]) * s0[j]; v[4 + j] = bf2f((unsigned short)xtf[t][4 + j]) * s1[j]; }
            xs[t] = pack_bf8(v);
        }
#pragma unroll
        for (int nbk = 0; nbk < 4; ++nbk) {
            asm volatile("" ::: "memory");
#pragma unroll
            for (int i = 0; i < 16; ++i) hT[nbk][i] *= dec;
#pragma unroll
            for (int t = 0; t < 4; ++t) hT[nbk] = __builtin_amdgcn_mfma_f32_32x32x16_bf16(load_2x4(BTr + (size_t)(32 * nbk) * LP + pp0 + 16 * t), xs[t], hT[nbk], 0, 0, 0);
        }
    }
}

__device__ __forceinline__ void final_norm(const Params& P, int vb, int nb) {
    const int tid = threadIdx.x, lane = tid & 63, wave = tid >> 6;
    for (int m = vb * 8 + wave; m < MX; m += nb * 8) {
        f32x4* xr = (f32x4*)(P.out + (size_t)m * DM) + lane;
        const f32x4* wr = (const f32x4*)P.final_w + lane;
        f32x4 v[4]; float ss = 0.f;
#pragma unroll
        for (int j = 0; j < 4; ++j) { v[j] = xr[64 * j]; ss += (v[j].x * v[j].x + v[j].y * v[j].y) + (v[j].z * v[j].z + v[j].w * v[j].w); }
        const float rstd = 1.0f / sqrtf(wave_sum(ss) * (1.0f / DM) + EPS);
#pragma unroll
        for (int j = 0; j < 4; ++j) { const f32x4 w = wr[64 * j]; xr[64 * j] = (f32x4){v[j].x * rstd * w.x, v[j].y * rstd * w.y, v[j].z * rstd * w.z, v[j].w * rstd * w.w}; }
    }
}

__global__ void __launch_bounds__(NTHREADS, 2) hybrid_fwd(Params P) {
    extern __shared__ __attribute__((aligned(16))) unsigned char lds_raw[];
    float* lds = (float*)lds_raw;
    PG8_LAS unsigned char* ldsl = (PG8_LAS unsigned char*)lds_raw;
    cg::grid_group grid = cg::this_grid();
    const int vb = blockIdx.x, nb = gridDim.x;
    const int lo = P.ph_lo, hi = P.ph_hi;
#define IN(k) (lo <= (k) && (k) < hi)
#define BOTH(k) (IN(k) && IN((k) + 1))
    if (IN(0)) { phase0(P, vb, nb); if (BOTH(0)) grid.sync(); }
    if (IN(1)) {
        pg8::Gemm g{(const bf16_t*)(P.ws + WS_XN), (const bf16_t*)(P.ws + WS_WTIN), MA, NPAD, DM};
        Order1 S{nb, vb};
        Epi1M E{(bf16_t*)P.out, (bf16_t*)(P.ws + WS_KB), (bf16_t*)(P.ws + WS_VT), (bf16_t*)(P.ws + WS_GZ), (bf16_t*)(P.ws + WS_XBC), (float*)(P.ws + WS_DT), P.dt_bias};
        pg8::gemm_phase<Epi1M, Order1, true, true>(ldsl, g, S, E);
        if (BOTH(1)) grid.sync();
    }
    if (IN(2)) { conv_phase(P, vb, nb); if (BOTH(2)) grid.sync(); }
    if (IN(3)) {
        const int wave = __builtin_amdgcn_readfirstlane(threadIdx.x >> 6);
        if (wave == 0) { for (int u = vb; u < NB * 16 * 2; u += nb) ssd_wave(P, (PG8_LAS float*)ldsl, u); }
        else attn_mfma(P, vb * 7 + (wave - 1), nb * 7);
        if (BOTH(3)) grid.sync();
    }
    if (IN(4)) {
        pg8::Gemm g{(const bf16_t*)(P.ws + WS_GZ), (const bf16_t*)(P.ws + WS_WTOUT), MX, DM, 2048};
        pg8::StaticOrder S; S.init(MX, DM, nb, vb);
        PG8_LAS float* RS = (PG8_LAS float*)(ldsl + pg8::STAGE_BYTES);
        pg8::Unit u0;
        if (S.next(0, u0) && threadIdx.x < 256) { float a, b; row_rstd((const float*)(P.ws + WS_SSQ), u0.pm * 256 + threadIdx.x, a, b); RS[2 * threadIdx.x] = a / b; RS[2 * threadIdx.x + 1] = b; }
        __syncthreads();
        Epi2M E{P.x, P.out, RS};
        pg8::gemm_phase<Epi2M, pg8::StaticOrder, false, true>(ldsl, g, S, E);
        if (BOTH(4)) grid.sync();
    }
    if (IN(5)) final_norm(P, vb, nb);
#undef IN
#undef BOTH
}

#ifndef MK_N_LAUNCHES
#define MK_N_LAUNCHES 1
#endif

extern "C" void kernel_launch(void* const* d_in, const int* in_sizes, int n_in, void* d_out, int out_size, void* d_ws, size_t ws_size, hipStream_t stream) {
    static int grid = 0;
    if (grid == 0) {
        if (n_in != 13 || out_size != MX * DM || ws_size < WS_END) { fprintf(stderr, "kernel_launch: unexpected sizes (n_in %d out %d ws %zu)\n", n_in, out_size, ws_size); grid = -1; return; }
        int dev = 0, cus = 0, per_cu = 0;
        (void)hipGetDevice(&dev);
        (void)hipDeviceGetAttribute(&cus, hipDeviceAttributeMultiprocessorCount, dev);
        (void)hipFuncSetAttribute((const void*)hybrid_fwd, hipFuncAttributeMaxDynamicSharedMemorySize, LDS_BYTES);
        (void)hipOccupancyMaxActiveBlocksPerMultiprocessor(&per_cu, (const void*)hybrid_fwd, NTHREADS, LDS_BYTES);
        if (per_cu < 1) { fprintf(stderr, "kernel_launch: occupancy query says %d blocks per CU\n", per_cu); grid = -1; return; }
        grid = cus;
    }
    if (grid < 0) return;
    Params p{};
    p.x = (const float*)d_in[0]; p.meta = (const float*)d_in[1]; p.norm_w = (const float*)d_in[2]; p.w_in = (const float*)d_in[3];
    p.conv_w = (const float*)d_in[4]; p.conv_b = (const float*)d_in[5]; p.dt_bias = (const float*)d_in[6]; p.a_log = (const float*)d_in[7];
    p.d_skip = (const float*)d_in[8]; p.sb_norm_w = (const float*)d_in[9]; p.ssd_norm_w = (const float*)d_in[10]; p.w_out = (const float*)d_in[11];
    p.final_w = (const float*)d_in[12]; p.out = (float*)d_out; p.ws = (unsigned char*)d_ws;
#if MK_N_LAUNCHES == 1
    p.ph_lo = 0; p.ph_hi = 6;
    void* args[] = {&p};
    hipError_t e = hipLaunchCooperativeKernel((const void*)hybrid_fwd, dim3(grid), dim3(NTHREADS), args, LDS_BYTES, stream);
    if (e != hipSuccess) fprintf(stderr, "cooperative launch failed: %s (grid %d)\n", hipGetErrorString(e), grid);
#else
    for (int ph = 0; ph < 6; ++ph) { p.ph_lo = ph; p.ph_hi = ph + 1; hipLaunchKernelGGL(hybrid_fwd, dim3(grid), dim3(NTHREADS), LDS_BYTES, stream, p); }
#endif
}
```

```cpp
#include <hip/hip_runtime.h>
#include <cstdio>
#include <cstdint>
#ifndef PROBE_DUP
#define PROBE_DUP 0
#endif

typedef unsigned short bf16_t;
typedef unsigned u32x4 __attribute__((ext_vector_type(4)));
typedef unsigned u32x2 __attribute__((ext_vector_type(2)));
typedef float f32x4 __attribute__((ext_vector_type(4)));

constexpr int DM = 1024, NB = 8, SEQ = 2048, NMETA = 16, LT = SEQ + NMETA  ;
constexpr int MX = NB * SEQ;
constexpr int MA = 16640;
constexpr int DIN = 6672, NPAD = 6912;
constexpr int XBCW = 1536;
constexpr float EPS = 1e-5f;
constexpr int NTHREADS = 512;

constexpr size_t MiB = 1u << 20;
constexpr size_t WS_CTL = 0;
constexpr size_t WS_WTOUT = 1 * MiB;
constexpr size_t WS_DT = 5 * MiB;
constexpr size_t WS_SSQ = 7 * MiB;
constexpr size_t WS_KB = 11 * MiB;
constexpr size_t WS_VT = 44 * MiB;
constexpr size_t WS_GZ = 77 * MiB;
constexpr size_t WS_XBC = 141 * MiB;
constexpr size_t WS_WTIN = 210 * MiB;
constexpr size_t WS_XN = 223 * MiB + MiB / 2;
constexpr size_t WS_XT = 190 * MiB;
constexpr size_t WS_XC = 223 * MiB;
constexpr size_t WS_END = 256 * MiB;
constexpr size_t DO_BC = 32 * MiB, DO_BT = 48 * MiB + MiB / 2, DO_DTP = 57 * MiB;
constexpr int LP = 2112;

constexpr int LDS_BYTES = 147456;
constexpr int LDS_MISC_OFF = 131072 + 4096;
constexpr int CW_BAR = 4096;
constexpr size_t CTL_ZERO_BYTES = 64 * 1024;

struct Params {
    const float *x, *meta, *norm_w, *w_in, *conv_w, *conv_b, *dt_bias, *a_log, *d_skip, *sb_norm_w, *ssd_norm_w, *w_out, *final_w;
    float* out; unsigned char* ws; int ph_lo, ph_hi;
};

__device__ __forceinline__ float bf2f(unsigned v) { return __uint_as_float(v << 16); }
__device__ __forceinline__ unsigned f2bf(float f) { unsigned u = __float_as_uint(f); return (u + 0x7fffu + ((u >> 16) & 1u)) >> 16; }
__device__ __forceinline__ unsigned pk2(float lo, float hi) { return f2bf(lo) | (f2bf(hi) << 16); }
typedef float f32x2_t __attribute__((ext_vector_type(2))); typedef __bf16 bf16x2_t __attribute__((ext_vector_type(2)));
__device__ __forceinline__ unsigned cvtpk(float lo, float hi) { const f32x2_t v = {lo, hi}; const bf16x2_t b = __builtin_convertvector(v, bf16x2_t); return __builtin_bit_cast(unsigned, b); }
__device__ __forceinline__ float wave_sum(float v) {
#pragma unroll
    for (int o = 1; o < 64; o <<= 1) v += __shfl_xor(v, o);
    return v;
}
__device__ __forceinline__ float silu_f(float v) { return v / (1.0f + __expf(-v)); }
__device__ __forceinline__ float softplus_f(float v) { return v > 20.0f ? v : log1pf(__expf(v)); }
__device__ __forceinline__ void unpack8(const u32x4 w, float* f) {
    f[0] = bf2f(w.x & 0xffffu); f[1] = bf2f(w.x >> 16); f[2] = bf2f(w.y & 0xffffu); f[3] = bf2f(w.y >> 16);
    f[4] = bf2f(w.z & 0xffffu); f[5] = bf2f(w.z >> 16); f[6] = bf2f(w.w & 0xffffu); f[7] = bf2f(w.w >> 16);
}

__device__ __forceinline__ void phase0(const Params& P, int vb, int nb) {
    const int tid = threadIdx.x, lane = tid & 63, wave = tid >> 6;
    bf16_t* XN = (bf16_t*)(P.ws + WS_XN);
    bf16_t* WTIN = (bf16_t*)(P.ws + WS_WTIN);
    bf16_t* WTOUT = (bf16_t*)(P.ws + WS_WTOUT);
    for (int m = vb * 8 + wave; m < MA; m += nb * 8) {
        u32x2* o8 = (u32x2*)(XN + (size_t)m * DM) + lane;
        if (m >= MX + NMETA) {
#pragma unroll
            for (int j = 0; j < 4; ++j) o8[64 * j] = (u32x2){0u, 0u};
        } else {
            const float* src = (m < MX) ? P.x + (size_t)m * DM : P.meta + (size_t)(m - MX) * DM;
            const f32x4* xr = (const f32x4*)src + lane;
            f32x4 v[4]; float ss = 0.f;
#pragma unroll
            for (int j = 0; j < 4; ++j) { v[j] = xr[64 * j]; ss += (v[j].x * v[j].x + v[j].y * v[j].y) + (v[j].z * v[j].z + v[j].w * v[j].w); }
            const float rstd = 1.0f / sqrtf(wave_sum(ss) * (1.0f / DM) + EPS);
#pragma unroll
            for (int j = 0; j < 4; ++j) o8[64 * j] = (u32x2){pk2(v[j].x * rstd, v[j].y * rstd), pk2(v[j].z * rstd, v[j].w * rstd)};
        }
    }
    const int gt = vb * NTHREADS + tid, ngt = nb * NTHREADS;
    for (int id = gt; id < NPAD * (DM / 8); id += ngt) {
        const int n = id % NPAD, kc = id / NPAD;
        u32x4 w = (u32x4){0u, 0u, 0u, 0u};
        if (n < DIN) {
            float f[8];
#pragma unroll
            for (int j = 0; j < 8; ++j) f[j] = P.w_in[(size_t)(8 * kc + j) * DIN + n] * P.norm_w[8 * kc + j];
            w = (u32x4){pk2(f[0], f[1]), pk2(f[2], f[3]), pk2(f[4], f[5]), pk2(f[6], f[7])};
        }
        *(u32x4*)(WTIN + (size_t)n * DM + 8 * kc) = w;
    }
    for (int id = gt; id < DM * (2048 / 8); id += ngt) {
        const int n = id % DM, kc = id / DM;
        float f[8];
#pragma unroll
        for (int j = 0; j < 8; ++j) { const int k = 8 * kc + j; const float s = (k < 1024) ? P.sb_norm_w[k] : P.ssd_norm_w[k - 1024]; f[j] = P.w_out[(size_t)k * DM + n] * s; }
        *(u32x4*)(WTOUT + (size_t)n * 2048 + 8 * kc) = (u32x4){pk2(f[0], f[1]), pk2(f[2], f[3]), pk2(f[4], f[5]), pk2(f[6], f[7])};
    }
}

namespace pg8 {
#define PG8_LAS __attribute__((address_space(3)))
typedef unsigned short bf16_t;
typedef short bf16x8 __attribute__((ext_vector_type(8)));
typedef float f32x4 __attribute__((ext_vector_type(4)));
typedef unsigned u32x4 __attribute__((ext_vector_type(4)));
constexpr int BM = 256, BK = 64, HALF = 128, HTB = HALF * BK * 2  , STAGE_BYTES = 8 * HTB, NXCD = 8, WGM = 8;

__host__ __device__ __forceinline__ int lds_byte(int r, int c) { const int st = (r >> 4) * 2 + (c >> 5), rr = r & 15, cc = c & 31, ob = rr * 64 + cc * 2; return st * 1024 + (ob ^ (((ob >> 9) & 1) << 5)); }
__host__ __device__ __forceinline__ void stage_rc(int b, int& R, int& C) { const int st = b / 1024, sb = b % 1024, swz = sb ^ (((sb >> 9) & 1) << 5); R = (st >> 1) * 16 + swz / 64; C = (st & 1) * 32 + (swz % 64) / 2; }
__host__ __device__ __forceinline__ int perm32(int rho) { const int n = rho >> 4, i = rho & 15; return 8 * (i >> 2) + 4 * n + (i & 3); }

struct Unit { int pm, pn, sw; };
struct Gemm { const bf16_t* A; const bf16_t* Bt; int M, N, K; };

struct StaticOrder {
    int nM, nN, nwg, G, c;
    __host__ __device__ void init(int M, int N, int G_, int c_) { nM = M / BM; nN = N / BM; nwg = nM * nN; G = G_; c = c_; }
    __host__ __device__ bool next(int i, Unit& u) const {
        const long L = (long)i * G + c; if (L >= nwg) return false;
        int wgid = (int)L; { const int q = nwg / NXCD, r = nwg % NXCD, xcd = wgid % NXCD, off = wgid / NXCD; wgid = (xcd < r ? xcd * (q + 1) : r * (q + 1) + (xcd - r) * q) + off; }
        const int nig = WGM * nN, gid = wgid / nig, fm = gid * WGM, gsz = (nM - fm) < WGM ? (nM - fm) : WGM;
        u.pm = fm + ((wgid % nig) % gsz); u.pn = (wgid % nig) / gsz; u.sw = 0; return true;
    }
    __device__ __forceinline__ void a_ready(const Unit&) const {}
    __device__ __forceinline__ void done(const Unit&) const {}
};

__device__ __forceinline__ const char* unit_a(const Gemm& g, const Unit& u, size_t tstep) { return u.sw ? (const char*)g.Bt + (size_t)u.pn * tstep : (const char*)g.A + (size_t)u.pm * tstep; }
__device__ __forceinline__ const char* unit_b(const Gemm& g, const Unit& u, size_t tstep) { return u.sw ? (const char*)g.A + (size_t)u.pm * tstep : (const char*)g.Bt + (size_t)u.pn * tstep; }
template <class Epi, class Sched, bool ALIGN_EPI = false, bool SP2 = false>
__device__ __forceinline__ void gemm_phase(PG8_LAS unsigned char* lds, const Gemm g, const Sched& S, const Epi& E) {
    const int tid = threadIdx.x, wid = __builtin_amdgcn_readfirstlane(tid >> 6), lane = tid & 63, wr = wid >> 2, wc = wid & 3, fr = lane & 15, fq = lane >> 4;
    const int K = g.K, nt = K / BK;
    unsigned voffA[2], voffB[2];
#pragma unroll
    for (int i = 0; i < 2; ++i) { int R, C; stage_rc(tid * 16 + i * 8192, R, C); const int Rb = Epi::PERM ? ((R & ~31) + perm32(R & 31)) : R;
        voffA[i] = (unsigned)(R * K + C) * 2u; voffB[i] = (unsigned)(Rb * K + C) * 2u; }
    const size_t kstep = (size_t)(BK * 2);
    const size_t hstep = (size_t)HALF * K * 2;
    const size_t tstep = 2 * hstep;
    const unsigned ldsw = (unsigned)wid * 1024u;
    const int aoff = lds_byte(wr * 64 + fr, fq * 8), boff = lds_byte(wc * 32 + fr, fq * 8);
#define PG8_SA(b, h) (((b) * 2 + (h)) * HTB)
#define PG8_SB(b, h) ((4 + (b) * 2 + (h)) * HTB)
#define PG8_STAGE(bufoff, gbase, voff) do { _Pragma("unroll") for (int _i = 0; _i < 2; ++_i) \
        __builtin_amdgcn_global_load_lds((const unsigned*)((const char*)(gbase) + (voff)[_i]), (PG8_LAS unsigned*)(lds + (bufoff) + ldsw + _i * 8192), 16, 0, 0); } while (0)
#define PG8_LDA(dst, b, h) do { _Pragma("unroll") for (int m = 0; m < 4; ++m) _Pragma("unroll") for (int k = 0; k < 2; ++k) dst[m][k] = *(const PG8_LAS bf16x8*)(lds + PG8_SA(b, h) + aoff + m * 2048 + k * 1024); } while (0)
#define PG8_LDB(dst, b, h) do { _Pragma("unroll") for (int n = 0; n < 2; ++n) _Pragma("unroll") for (int k = 0; k < 2; ++k) dst[n][k] = *(const PG8_LAS bf16x8*)(lds + PG8_SB(b, h) + boff + n * 2048 + k * 1024); } while (0)
#define PG8_MMA(ai, bj, At, Bt) do { __builtin_amdgcn_s_setprio(1); _Pragma("unroll") for (int m = 0; m < 4; ++m) _Pragma("unroll") for (int n = 0; n < 2; ++n) _Pragma("unroll") for (int k = 0; k < 2; ++k) \
        acc[ai][bj][m][n] = __builtin_amdgcn_mfma_f32_16x16x32_bf16(Bt[n][k], At[m][k], acc[ai][bj][m][n], 0, 0, 0); __builtin_amdgcn_s_setprio(0); } while (0)
#define PG8_WAIT_V(n) asm volatile("s_waitcnt vmcnt(" #n ")" ::: "memory")
#define PG8_WAIT_L(n) asm volatile("s_waitcnt lgkmcnt(" #n ")" ::: "memory")
#define PG8_BAR __builtin_amdgcn_s_barrier()
#define PG8_SCHED __builtin_amdgcn_sched_barrier(0)
    Unit cur, nxt; int ui = 0;
    if (!S.next(0, cur)) return;
    f32x4 acc[2][2][4][2];
#pragma unroll
    for (int a = 0; a < 2; ++a)
#pragma unroll
        for (int b = 0; b < 2; ++b)
#pragma unroll
            for (int m = 0; m < 4; ++m)
#pragma unroll
                for (int n = 0; n < 2; ++n) acc[a][b][m][n] = (f32x4){0.f, 0.f, 0.f, 0.f};
    bf16x8 At[4][2], B0[2][2], B1[2][2];
    const char* cA = unit_a(g, cur, tstep); const char* cB = unit_b(g, cur, tstep);
    S.a_ready(cur);
    if constexpr (SP2) {
        PG8_STAGE(PG8_SB(0, 0), cB, voffB); PG8_STAGE(PG8_SB(0, 1), cB + hstep, voffB); PG8_STAGE(PG8_SA(0, 0), cA, voffA); PG8_STAGE(PG8_SA(0, 1), cA + hstep, voffA);
        if (wr == 1) PG8_BAR;
        PG8_WAIT_V(2); PG8_BAR;
        PG8_STAGE(PG8_SB(1, 0), cB + kstep, voffB); PG8_STAGE(PG8_SA(1, 0), cA + kstep, voffA); PG8_STAGE(PG8_SB(1, 1), cB + hstep + kstep, voffB);
        PG8_WAIT_V(6); PG8_BAR;
    } else {
        PG8_STAGE(PG8_SB(0, 0), cB, voffB); PG8_STAGE(PG8_SA(0, 0), cA, voffA); PG8_STAGE(PG8_SB(0, 1), cB + hstep, voffB); PG8_STAGE(PG8_SA(0, 1), cA + hstep, voffA);
        if (wr == 1) PG8_BAR;
        PG8_WAIT_V(4); PG8_BAR;
        PG8_STAGE(PG8_SB(1, 0), cB + kstep, voffB); PG8_STAGE(PG8_SA(1, 0), cA + kstep, voffA); PG8_STAGE(PG8_SB(1, 1), cB + hstep + kstep, voffB);
        PG8_WAIT_V(6); PG8_BAR;
    }
    for (;;) {
        const bool has_next = S.next(ui + 1, nxt);
        const char* nA = has_next ? unit_a(g, nxt, tstep) : cA; const char* nB = has_next ? unit_b(g, nxt, tstep) : cB;
        for (int t = 0; t < nt; t += 2) {
            const bool last = (t == nt - 2);
            const char* a1 = cA + (size_t)(t + 1) * kstep;
            const char* a2 = last ? nA : cA + (size_t)(t + 2) * kstep; const char* b2 = last ? nB : cB + (size_t)(t + 2) * kstep;
            const char* a3 = a2 + kstep; const char* b3 = b2 + kstep;
            if (last && has_next) S.a_ready(nxt);
            if constexpr (Epi::HAS_MID) { if (t == nt / 2) E.mid(acc, wr, fr); }
            if constexpr (SP2) {
            PG8_LDB(B0, 0, 0); PG8_LDB(B1, 0, 1); PG8_SCHED; PG8_LDA(At, 0, 0); PG8_STAGE(PG8_SA(1, 1), a1 + hstep, voffA);
            PG8_WAIT_V(8); PG8_WAIT_L(0); PG8_BAR; PG8_MMA(0, 0, At, B0); PG8_MMA(0, 1, At, B1); PG8_BAR; PG8_SCHED;
            PG8_LDA(At, 0, 1); PG8_STAGE(PG8_SB(0, 0), b2, voffB); PG8_STAGE(PG8_SB(0, 1), b2 + hstep, voffB); PG8_STAGE(PG8_SA(0, 0), a2, voffA);
            PG8_WAIT_V(8); PG8_WAIT_L(0); PG8_BAR; PG8_MMA(1, 0, At, B0); PG8_MMA(1, 1, At, B1); PG8_BAR; PG8_SCHED;
            PG8_LDB(B0, 1, 0); PG8_LDB(B1, 1, 1); PG8_SCHED; PG8_LDA(At, 1, 0); PG8_STAGE(PG8_SA(0, 1), a2 + hstep, voffA);
            PG8_WAIT_V(8); PG8_WAIT_L(0); PG8_BAR; PG8_MMA(0, 0, At, B0); PG8_MMA(0, 1, At, B1); PG8_BAR; PG8_SCHED;
            PG8_LDA(At, 1, 1); PG8_STAGE(PG8_SB(1, 0), b3, voffB); PG8_STAGE(PG8_SB(1, 1), b3 + hstep, voffB); PG8_STAGE(PG8_SA(1, 0), a3, voffA);
            PG8_WAIT_V(8); PG8_WAIT_L(0); PG8_BAR; PG8_MMA(1, 0, At, B0); PG8_MMA(1, 1, At, B1); PG8_BAR; PG8_SCHED;
            } else {
            PG8_LDB(B0, 0, 0); PG8_SCHED; PG8_LDA(At, 0, 0); PG8_STAGE(PG8_SA(1, 1), a1 + hstep, voffA);
            PG8_WAIT_L(8); PG8_BAR; PG8_WAIT_L(0); PG8_MMA(0, 0, At, B0); PG8_BAR; PG8_SCHED;
            PG8_LDB(B1, 0, 1); PG8_STAGE(PG8_SB(0, 0), b2, voffB);
            PG8_BAR; PG8_WAIT_L(0); PG8_MMA(0, 1, At, B1); PG8_BAR;
            PG8_LDA(At, 0, 1); PG8_STAGE(PG8_SA(0, 0), a2, voffA);
            PG8_BAR; PG8_WAIT_L(0); PG8_MMA(1, 0, At, B0); PG8_BAR; PG8_SCHED;
            PG8_STAGE(PG8_SB(0, 1), b2 + hstep, voffB);
            PG8_WAIT_V(6); PG8_BAR; PG8_MMA(1, 1, At, B1); PG8_BAR;
            PG8_LDB(B0, 1, 0); PG8_SCHED; PG8_LDA(At, 1, 0); PG8_STAGE(PG8_SA(0, 1), a2 + hstep, voffA);
            PG8_WAIT_L(8); PG8_BAR; PG8_WAIT_L(0); PG8_MMA(0, 0, At, B0); PG8_BAR; PG8_SCHED;
            PG8_LDB(B1, 1, 1); PG8_STAGE(PG8_SB(1, 0), b3, voffB);
            PG8_BAR; PG8_WAIT_L(0); PG8_MMA(0, 1, At, B1); PG8_BAR;
            PG8_LDA(At, 1, 1); PG8_STAGE(PG8_SA(1, 0), a3, voffA);
            PG8_BAR; PG8_WAIT_L(0); PG8_MMA(1, 0, At, B0); PG8_BAR; PG8_SCHED;
            PG8_STAGE(PG8_SB(1, 1), b3 + hstep, voffB);
            PG8_WAIT_V(6); PG8_BAR; PG8_MMA(1, 1, At, B1); PG8_BAR;
            }
        }
        if constexpr (ALIGN_EPI) { if (wr == 0) PG8_BAR; }
        if constexpr (!Epi::AFTER_DRAIN) { E(acc, cur, wr, wc, fr, fq); S.done(cur); }
        if (!has_next) break;
#pragma unroll
        for (int a = 0; a < 2; ++a)
#pragma unroll
            for (int b = 0; b < 2; ++b)
#pragma unroll
                for (int m = 0; m < 4; ++m)
#pragma unroll
                    for (int n = 0; n < 2; ++n) acc[a][b][m][n] = (f32x4){0.f, 0.f, 0.f, 0.f};
        cur = nxt; cA = nA; cB = nB; ++ui;
        if constexpr (ALIGN_EPI) { if (wr == 1) PG8_BAR; }
    }
    PG8_WAIT_V(0);
    if constexpr (!ALIGN_EPI) { if (wr == 0) PG8_BAR; }
    PG8_BAR;
    if constexpr (Epi::AFTER_DRAIN) { E.fused(acc, cur, wr, wc, fr, fq, lds, wid, lane); S.done(cur); }
#undef PG8_SA
#undef PG8_SB
#undef PG8_STAGE
#undef PG8_LDA
#undef PG8_LDB
#undef PG8_MMA
#undef PG8_WAIT_V
#undef PG8_WAIT_L
#undef PG8_BAR
#undef PG8_SCHED
}
}

__device__ __forceinline__ unsigned cvt_pk_bf16(float lo, float hi) { unsigned r; asm volatile("v_cvt_pk_bf16_f32 %0, %1, %2" : "=v"(r) : "v"(lo), "v"(hi)); return r; }
__device__ __forceinline__ u32x4 pack8(const f32x4 v0, const f32x4 v1) { u32x4 w; w.x = cvt_pk_bf16(v0[0], v0[1]); w.y = cvt_pk_bf16(v0[2], v0[3]); w.z = cvt_pk_bf16(v1[0], v1[1]); w.w = cvt_pk_bf16(v1[2], v1[3]); return w; }
__device__ __forceinline__ f32x4 silu4(const f32x4 v) { f32x4 o;
#pragma unroll
    for (int j = 0; j < 4; ++j) o[j] = v[j] * __builtin_amdgcn_rcpf(1.0f + __expf(-v[j]));
    return o; }

struct Order1 {
    int G, c;
    __device__ __forceinline__ bool next(int i, pg8::Unit& u) const {
        constexpr int nM = 64, nN = 27, nwg = nM * nN;
        const int L = i * G + c;
        if (L < nwg) { const int xcd = L % 8, off = L / 8, wgid = xcd * (nwg / 8) + off; const int nig = 8 * nN, gid = wgid / nig, fm = gid * 8;
            u.pm = fm + ((wgid % nig) % 8); u.pn = (wgid % nig) / 8; u.sw = (u.pn >= 8 && u.pn < 12) ? 1 : 0; return true; }
        const int j = L - nwg; if (j >= 15) return false;
        u.pm = 64; u.pn = j < 8 ? 4 + j : 12 + j; u.sw = (u.pn >= 8 && u.pn < 12) ? 1 : 0; return true;
    }
    __device__ __forceinline__ void a_ready(const pg8::Unit&) const {}
    __device__ __forceinline__ void done(const pg8::Unit&) const {}
};

struct Epi1M {
    static constexpr bool PERM = true, AFTER_DRAIN = false, HAS_MID = false;
    bf16_t *Q, *KB, *VT, *GZ, *XBC; float* DT; const float* dt_bias;
    __device__ __forceinline__ void mid(f32x4 (&)[2][2][4][2], int, int) const {}
    __device__ __forceinline__ void operator()(const f32x4 (&acc)[2][2][4][2], const pg8::Unit& u, int wr, int wc, int fr, int fq) const {
        const int pn = u.pn, pm = u.pm;
        asm volatile("" : "+v"(fr), "+v"(fq));
        const int rl0 = wr * 64 + fr, cl0 = wc * 32 + 8 * fq;
        if (u.sw) {
            const int vc0 = (pn - 8) * 256 + rl0;
            if (pm < 64) {
                const int b = pm >> 3, i0 = (pm & 7) * 256 + cl0;
#pragma unroll
                for (int ai = 0; ai < 2; ++ai)
#pragma unroll
                    for (int m = 0; m < 4; ++m) { bf16_t* rowp = VT + ((size_t)(b * 1024 + vc0 + ai * 128 + m * 16)) * LT + NMETA + i0;
#pragma unroll
                        for (int bj = 0; bj < 2; ++bj) *(u32x4*)(rowp + bj * 128) = pack8(acc[ai][bj][m][0], acc[ai][bj][m][1]); }
            } else if (wc == 0 && fq < 2) {
#pragma unroll
                for (int ai = 0; ai < 2; ++ai)
#pragma unroll
                    for (int m = 0; m < 4; ++m) { const u32x4 w = pack8(acc[ai][0][m][0], acc[ai][0][m][1]);
                        _Pragma("unroll 1") for (int b = 0; b < NB; ++b) *(u32x4*)(VT + ((size_t)(b * 1024 + vc0 + ai * 128 + m * 16)) * LT + 8 * fq) = w; }
            }
            return;
        }
        if (pm < 64) {
            const int b = pm >> 3;
            if (pn < 4) {
#pragma unroll
                for (int ai = 0; ai < 2; ++ai)
#pragma unroll
                    for (int m = 0; m < 4; ++m) { bf16_t* rowp = Q + (size_t)(pm * 256 + rl0 + ai * 128 + m * 16) * 1024 + pn * 256 + cl0;
#pragma unroll
                        for (int bj = 0; bj < 2; ++bj) *(u32x4*)(rowp + bj * 128) = pack8(acc[ai][bj][m][0] * 0.125f, acc[ai][bj][m][1] * 0.125f); }
            } else if (pn < 8) {
#pragma unroll
                for (int ai = 0; ai < 2; ++ai)
#pragma unroll
                    for (int m = 0; m < 4; ++m) { bf16_t* rowp = KB + (size_t)(pm * 256 + rl0 + ai * 128 + m * 16 + NMETA * (b + 1)) * 1024 + (pn - 4) * 256 + cl0;
#pragma unroll
                        for (int bj = 0; bj < 2; ++bj) *(u32x4*)(rowp + bj * 128) = pack8(acc[ai][bj][m][0], acc[ai][bj][m][1]); }
            } else if (pn < 20) {
#pragma unroll
                for (int ai = 0; ai < 2; ++ai)
#pragma unroll
                    for (int m = 0; m < 4; ++m) { bf16_t* rowp = GZ + (size_t)(pm * 256 + rl0 + ai * 128 + m * 16) * 2048 + (pn - 12) * 256 + cl0;
#pragma unroll
                        for (int bj = 0; bj < 2; ++bj) *(u32x4*)(rowp + bj * 128) = pack8(silu4(acc[ai][bj][m][0]), silu4(acc[ai][bj][m][1])); }
            } else if (pn < 26) {
#pragma unroll
                for (int ai = 0; ai < 2; ++ai)
#pragma unroll
                    for (int m = 0; m < 4; ++m) { bf16_t* rowp = XBC + (size_t)(pm * 256 + rl0 + ai * 128 + m * 16 + NMETA * (b + 1)) * XBCW + (pn - 20) * 256 + cl0;
#pragma unroll
                        for (int bj = 0; bj < 2; ++bj) *(u32x4*)(rowp + bj * 128) = pack8(acc[ai][bj][m][0], acc[ai][bj][m][1]); }
            } else if (wc == 0 && fq < 2) {
                const f32x4 b0 = *(const f32x4*)(dt_bias + 8 * fq), b1 = *(const f32x4*)(dt_bias + 8 * fq + 4);
#pragma unroll
                for (int ai = 0; ai < 2; ++ai)
#pragma unroll
                    for (int m = 0; m < 4; ++m) { float* rowp = DT + (size_t)(pm * 256 + rl0 + ai * 128 + m * 16 + NMETA * (b + 1)) * 16 + 8 * fq;
                        f32x4 o0, o1;
#pragma unroll
                        for (int j = 0; j < 4; ++j) { o0[j] = softplus_f(acc[ai][0][m][0][j] + b0[j]); o1[j] = softplus_f(acc[ai][0][m][1][j] + b1[j]); }
                        *(f32x4*)rowp = o0; *(f32x4*)(rowp + 4) = o1; }
            }
            return;
        }
        if (wr != 0) return;
        if (pn < 8) {
            _Pragma("unroll 1") for (int b = 0; b < NB; ++b) { bf16_t* rowp = KB + (size_t)(b * LT + fr) * 1024 + (pn - 4) * 256 + cl0;
#pragma unroll
                for (int bj = 0; bj < 2; ++bj) *(u32x4*)(rowp + bj * 128) = pack8(acc[0][bj][0][0], acc[0][bj][0][1]); }
        } else if (pn < 26) {
            _Pragma("unroll 1") for (int b = 0; b < NB; ++b) { bf16_t* rowp = XBC + (size_t)(b * LT + fr) * XBCW + (pn - 20) * 256 + cl0;
#pragma unroll
                for (int bj = 0; bj < 2; ++bj) *(u32x4*)(rowp + bj * 128) = pack8(acc[0][bj][0][0], acc[0][bj][0][1]); }
        } else if (wc == 0 && fq < 2) {
            const f32x4 b0 = *(const f32x4*)(dt_bias + 8 * fq), b1 = *(const f32x4*)(dt_bias + 8 * fq + 4);
            f32x4 o0, o1;
#pragma unroll
            for (int j = 0; j < 4; ++j) { o0[j] = softplus_f(acc[0][0][0][0][j] + b0[j]); o1[j] = softplus_f(acc[0][0][0][1][j] + b1[j]); }
            _Pragma("unroll 1") for (int b = 0; b < NB; ++b) { float* rowp = DT + (size_t)(b * LT + fr) * 16 + 8 * fq; *(f32x4*)rowp = o0; *(f32x4*)(rowp + 4) = o1; }
        }
    }
};

__device__ __forceinline__ void row_rstd(const float* SSQ, int m, float& rs_sb, float& rs_ssd) {
    const f32x4* p = (const f32x4*)(SSQ + (size_t)m * 64);
    float s1 = 0.f, s2 = 0.f;
#pragma unroll
    for (int j = 0; j < 4; ++j) { const f32x4 a = p[j]; s1 += (a.x + a.y) + (a.z + a.w); }
#pragma unroll
    for (int j = 4; j < 12; ++j) { const f32x4 a = p[j]; s2 += (a.x + a.y) + (a.z + a.w); }
    rs_sb = 1.0f / sqrtf(s1 * (1.0f / 1024.0f) + EPS); rs_ssd = 1.0f / sqrtf(s2 * (1.0f / 1024.0f) + EPS);
}

struct Epi2M {
    static constexpr bool PERM = false, AFTER_DRAIN = false, HAS_MID = true;
    const float* x; float* out; const PG8_LAS float* RS;
    __device__ __forceinline__ void mid(f32x4 (&acc)[2][2][4][2], int wr, int fr) const {
#pragma unroll
        for (int ai = 0; ai < 2; ++ai)
#pragma unroll
            for (int m = 0; m < 4; ++m) { const float r = RS[2 * (ai * 128 + wr * 64 + m * 16 + fr)];
#pragma unroll
                for (int bj = 0; bj < 2; ++bj)
#pragma unroll
                    for (int n = 0; n < 2; ++n) acc[ai][bj][m][n] *= r; }
    }
    __device__ __forceinline__ void operator()(const f32x4 (&acc)[2][2][4][2], const pg8::Unit& u, int wr, int wc, int fr, int fq) const {
        const int col0 = u.pn * 256 + wc * 32 + 4 * fq;
#pragma unroll
        for (int ai = 0; ai < 2; ++ai)
#pragma unroll
            for (int m = 0; m < 4; ++m) { const int r = ai * 128 + wr * 64 + m * 16 + fr; const float rs = RS[2 * r + 1]; const size_t off = (size_t)(u.pm * 256 + r) * DM + col0;
#pragma unroll
                for (int bj = 0; bj < 2; ++bj)
#pragma unroll
                    for (int n = 0; n < 2; ++n) { const f32x4 xv = *(const f32x4*)(x + off + bj * 128 + n * 16); *(f32x4*)(out + off + bj * 128 + n * 16) = xv + acc[ai][bj][m][n] * rs; } }
    }
};

typedef short bf16x8 __attribute__((ext_vector_type(8)));
typedef short s16x4 __attribute__((ext_vector_type(4)));
typedef float f32x16 __attribute__((ext_vector_type(16)));
#ifndef ATT_THR2
#define ATT_THR2 150.0f
#endif
#ifndef ATT_EARLY
#define ATT_EARLY 1
#endif
template <bool DRY> __device__ __forceinline__ void attn_mfma(const Params& P, int gw, int ngw) {
    const bf16_t* Q = (const bf16_t*)P.out;
    const bf16_t* KB = (const bf16_t*)(P.ws + WS_KB);
    const bf16_t* VT = (const bf16_t*)(P.ws + WS_VT);
    bf16_t* GZ = (bf16_t*)(P.ws + WS_GZ);
    float* SSQ = (float*)(P.ws + WS_SSQ);
    const int lane = threadIdx.x & 63, r32 = lane & 31, hh = lane >> 5;
    constexpr float L2E = 1.4426950408889634f;
    for (int item = gw; item < NB * 16 * 64; item += ngw) {
        const int rnd = item / ngw, qraw = item & 63, qblk = (rnd & 1) ? 63 - qraw : qraw, h = (item >> 6) & 15, b = item >> 10;
        const int tq = NMETA + 32 * qblk + r32;
        const size_t m = (size_t)b * SEQ + 32 * qblk + r32;
        bf16x8 qf[4];
#pragma unroll
        for (int ks = 0; ks < 4; ++ks) qf[ks] = *(const bf16x8*)(Q + m * 1024 + h * 64 + 16 * ks + 8 * hh);
        f32x16 o0, o1;
#pragma unroll
        for (int i = 0; i < 16; ++i) { o0[i] = 0.f; o1[i] = 0.f; }
        float carry = 0.f;
        const bf16_t* Kh = KB + (size_t)b * LT * 1024 + h * 64 + 8 * hh;
        const bf16_t* Vh = VT + ((size_t)b * 1024 + h * 64 + r32) * LT;
        for (int kt = qblk + 1; kt >= 0; --kt) {
            const int s0 = 32 * kt;
            int krow = s0 + r32; krow = krow < LT ? krow : LT - 1;
            bf16x8 kf[4];
#pragma unroll
            for (int ks = 0; ks < 4; ++ks) kf[ks] = *(const bf16x8*)(Kh + (size_t)krow * 1024 + 16 * ks);
            s16x4 vlo[2][2], vhi[2][2];
#pragma unroll
            for (int s = 0; s < 2; ++s) {
                int k0 = s0 + 16 * s + 4 * hh, k1 = k0 + 8;
                k0 = k0 < LT ? k0 : LT - 4; k1 = k1 < LT ? k1 : LT - 4;
#pragma unroll
                for (int db = 0; db < 2; ++db) { vlo[db][s] = *(const s16x4*)(Vh + (size_t)db * 32 * LT + k0); vhi[db][s] = *(const s16x4*)(Vh + (size_t)db * 32 * LT + k1); }
            }
            f32x16 st;
#pragma unroll
            for (int i = 0; i < 16; ++i) st[i] = 0.f;
#pragma unroll
            for (int ks = 0; ks < 4; ++ks) st = __builtin_amdgcn_mfma_f32_32x32x16_bf16(kf[ks], qf[ks], st, 0, 0, 0);
            float ls[16], z2[16];
#pragma unroll
            for (int i = 0; i < 16; ++i) {
                z2[i] = st[i] * L2E;
                const float e = __builtin_amdgcn_exp2f(-__builtin_fabsf(z2[i]));
                ls[i] = -(__builtin_fmaxf(z2[i], 0.f) + __builtin_amdgcn_logf(1.0f + e));
            }
            const bool masked = kt >= qblk;
            if (masked) {
#pragma unroll
                for (int i = 0; i < 16; ++i) { const int key = s0 + (i & 3) + 8 * (i >> 2) + 4 * hh; if (key >= tq) ls[i] = 0.f; }
            }
            float T[4], To[4];
#pragma unroll
            for (int g = 0; g < 4; ++g) { ls[4 * g + 2] += ls[4 * g + 3]; ls[4 * g + 1] += ls[4 * g + 2]; ls[4 * g] += ls[4 * g + 1]; T[g] = ls[4 * g]; }
#pragma unroll
            for (int g = 0; g < 4; ++g) To[g] = __shfl_xor(T[g], 32);
            const float P0 = T[0] + To[0], P1 = T[1] + To[1], P2 = T[2] + To[2], P3 = T[3] + To[3];
            float off[4];
            off[3] = carry; off[2] = off[3] + P3; off[1] = off[2] + P2; off[0] = off[1] + P1;
            carry = off[0] + P0;
            if (hh == 0) {
#pragma unroll
                for (int g = 0; g < 4; ++g) off[g] += To[g];
            }
            float w[16];
#pragma unroll
            for (int i = 0; i < 16; ++i) w[i] = __builtin_amdgcn_exp2f(z2[i] + ls[i] + off[i >> 2]);
            if (masked) {
#pragma unroll
                for (int i = 0; i < 16; ++i) { const int key = s0 + (i & 3) + 8 * (i >> 2) + 4 * hh; if (key >= tq) w[i] = 0.f; }
            }
            bf16x8 wf[2];
#pragma unroll
            for (int s = 0; s < 2; ++s) {
                const unsigned a0 = cvtpk(w[8 * s], w[8 * s + 1]), a1 = cvtpk(w[8 * s + 2], w[8 * s + 3]), a2 = cvtpk(w[8 * s + 4], w[8 * s + 5]), a3 = cvtpk(w[8 * s + 6], w[8 * s + 7]);
                const u32x4 pk = (u32x4){a0, a1, a2, a3};
                wf[s] = __builtin_bit_cast(bf16x8, pk);
            }
#pragma unroll
            for (int s = 0; s < 2; ++s) {
                const bf16x8 va0 = (bf16x8){vlo[0][s][0], vlo[0][s][1], vlo[0][s][2], vlo[0][s][3], vhi[0][s][0], vhi[0][s][1], vhi[0][s][2], vhi[0][s][3]};
                const bf16x8 va1 = (bf16x8){vlo[1][s][0], vlo[1][s][1], vlo[1][s][2], vlo[1][s][3], vhi[1][s][0], vhi[1][s][1], vhi[1][s][2], vhi[1][s][3]};
                o0 = __builtin_amdgcn_mfma_f32_32x32x16_bf16(va0, wf[s], o0, 0, 0, 0);
                o1 = __builtin_amdgcn_mfma_f32_32x32x16_bf16(va1, wf[s], o1, 0, 0, 0);
            }
#if ATT_EARLY
            if (__all(carry < -ATT_THR2)) break;
#endif
        }
        float ss = 0.f;
#pragma unroll
        for (int db = 0; db < 2; ++db)
#pragma unroll
            for (int g = 0; g < 4; ++g) {
                u32x2* gp = (u32x2*)(GZ + m * 2048 + h * 64 + 32 * db + 8 * g + 4 * hh);
                const u32x2 gv = *gp;
                const float g0 = bf2f(gv.x & 0xffffu), g1 = bf2f(gv.x >> 16), g2 = bf2f(gv.y & 0xffffu), g3 = bf2f(gv.y >> 16);
                const float y0 = (db ? o1[4 * g] : o0[4 * g]) * g0, y1 = (db ? o1[4 * g + 1] : o0[4 * g + 1]) * g1, y2 = (db ? o1[4 * g + 2] : o0[4 * g + 2]) * g2, y3 = (db ? o1[4 * g + 3] : o0[4 * g + 3]) * g3;
                ss += (y0 * y0 + y1 * y1) + (y2 * y2 + y3 * y3);
                if (!DRY) *gp = (u32x2){cvtpk(y0, y1), cvtpk(y2, y3)};
            }
        ss += __shfl_xor(ss, 32);
        if (DRY) { if (ss == 12345.678f) SSQ[m * 64 + h] = ss; } else
        if (hh == 0) SSQ[m * 64 + h] = ss;
    }
}

__device__ __forceinline__ void conv_phase(const Params& P, int vb, int nb) {
    const bf16_t* XBC = (const bf16_t*)(P.ws + WS_XBC);
    const float* DT = (const float*)(P.ws + WS_DT);
    bf16_t* XT = (bf16_t*)(P.ws + WS_XT); bf16_t* XC = (bf16_t*)(P.ws + WS_XC);
    bf16_t* BC = (bf16_t*)((unsigned char*)P.out + DO_BC); bf16_t* BT = (bf16_t*)((unsigned char*)P.out + DO_BT); float* DTP = (float*)((unsigned char*)P.out + DO_DTP);
    const int gt = vb * NTHREADS + threadIdx.x, ngt = nb * NTHREADS;
    const u32x4 zero4 = (u32x4){0u, 0u, 0u, 0u};
    for (int id = gt; id < NB * 48 * 128; id += ngt) { const int c = id & 127, r = id >> 7, pp = r % 48, b = r / 48; *(u32x4*)(XC + ((size_t)b * LP + pp) * 1024 + 8 * c) = zero4; }
    for (int id = gt; id < NB * 48 * 64; id += ngt) { const int c = id & 63, r = id >> 6, pp = r % 48, b = r / 48; *(u32x4*)(BC + ((size_t)b * LP + pp) * 512 + 8 * c) = zero4; }
    for (int id = gt; id < NB * 1024 * 6; id += ngt) { const int j = id % 6, row = id / 6; *(u32x4*)(XT + (size_t)row * LP + 8 * j) = zero4; }
    for (int id = gt; id < NB * 256 * 6; id += ngt) { const int j = id % 6, row = id / 6; *(u32x4*)(BT + (size_t)row * LP + 8 * j) = zero4; }
    for (int id = gt; id < NB * LP * 4; id += ngt) { const int q = id & 3, r = id >> 2, pp = r % LP, b = r / LP;
        f32x4 v = (f32x4){0.f, 0.f, 0.f, 0.f}; if (pp >= 48) v = *(const f32x4*)(DT + ((size_t)b * LT + (pp - 48)) * 16 + 4 * q);
        *(f32x4*)(DTP + ((size_t)b * LP + pp) * 16 + 4 * q) = v; }
    for (int id = gt; id < NB * 258 * 192; id += ngt) {
        const int cg = id % 192, r = id / 192, tb = r % 258, b = r / 258, tok0 = 8 * tb, c0 = 8 * cg, pp = 48 + tok0;
        float wj[4][8], bias[8];
#pragma unroll
        for (int j = 0; j < 4; ++j) { const f32x4 w0 = *(const f32x4*)(P.conv_w + j * XBCW + c0), w1 = *(const f32x4*)(P.conv_w + j * XBCW + c0 + 4);
            wj[j][0] = w0.x; wj[j][1] = w0.y; wj[j][2] = w0.z; wj[j][3] = w0.w; wj[j][4] = w1.x; wj[j][5] = w1.y; wj[j][6] = w1.z; wj[j][7] = w1.w; }
        { const f32x4 b0 = *(const f32x4*)(P.conv_b + c0), b1 = *(const f32x4*)(P.conv_b + c0 + 4); bias[0] = b0.x; bias[1] = b0.y; bias[2] = b0.z; bias[3] = b0.w; bias[4] = b1.x; bias[5] = b1.y; bias[6] = b1.z; bias[7] = b1.w; }
        float raw[11][8];
#pragma unroll
        for (int rr = 0; rr < 11; ++rr) { const int tok = tok0 - 3 + rr; u32x4 w = zero4; if (tok >= 0) w = *(const u32x4*)(XBC + ((size_t)b * LT + tok) * XBCW + c0); unpack8(w, raw[rr]); }
        bf16_t *rdA, *rdB; int rowpitch;
        if (cg < 128) { const int base = c0 & ~31, q = (c0 >> 3) & 3; rdA = XC + ((size_t)b * LP + pp) * 1024 + base + 4 * q; rdB = rdA + 16; rowpitch = 1024; }
        else { const int cb = c0 - 1024, base = cb & ~15, hs = (cb >> 3) & 1; rdA = BC + ((size_t)b * LP + pp) * 512 + base + 4 * hs; rdB = rdA + 8; rowpitch = 512; }
        unsigned tw[8][4];
#pragma unroll
        for (int tp = 0; tp < 4; ++tp) {
            float o0[8], o1[8];
#pragma unroll
            for (int cc = 0; cc < 8; ++cc) {
                float v0 = bias[cc], v1 = bias[cc];
#pragma unroll
                for (int j = 0; j < 4; ++j) { v0 += wj[j][cc] * raw[2 * tp + j][cc]; v1 += wj[j][cc] * raw[2 * tp + 1 + j][cc]; }
                o0[cc] = silu_f(v0); o1[cc] = silu_f(v1); tw[cc][tp] = cvtpk(o0[cc], o1[cc]);
            }
            *(u32x2*)(rdA + (size_t)(2 * tp) * rowpitch) = (u32x2){cvtpk(o0[0], o0[1]), cvtpk(o0[2], o0[3])};
            *(u32x2*)(rdB + (size_t)(2 * tp) * rowpitch) = (u32x2){cvtpk(o0[4], o0[5]), cvtpk(o0[6], o0[7])};
            *(u32x2*)(rdA + (size_t)(2 * tp + 1) * rowpitch) = (u32x2){cvtpk(o1[0], o1[1]), cvtpk(o1[2], o1[3])};
            *(u32x2*)(rdB + (size_t)(2 * tp + 1) * rowpitch) = (u32x2){cvtpk(o1[4], o1[5]), cvtpk(o1[6], o1[7])};
        }
        if (cg < 160) {
            const int gbase = pp & ~15, hs = (pp >> 3) & 1;
            bf16_t* tdst = ((cg < 128) ? XT + ((size_t)b * 1024 + c0) * LP : BT + ((size_t)b * 256 + (c0 - 1024)) * LP) + gbase + 4 * hs;
#pragma unroll
            for (int cc = 0; cc < 8; ++cc) { *(u32x2*)(tdst + (size_t)cc * LP) = (u32x2){tw[cc][0], tw[cc][1]}; *(u32x2*)(tdst + (size_t)cc * LP + 8) = (u32x2){tw[cc][2], tw[cc][3]}; }
        }
    }
}

__device__ __forceinline__ bf16x8 pack_bf8(const float* v) { const u32x4 pk = (u32x4){cvtpk(v[0], v[1]), cvtpk(v[2], v[3]), cvtpk(v[4], v[5]), cvtpk(v[6], v[7])}; return __builtin_bit_cast(bf16x8, pk); }
constexpr int SB_BM = 0, SB_CM = 16, SB_XT = 32, SB_BT = 36, SB_XC = 52, SB_Z = 56  , SB_DT = 60  , SSD_BUF = 62 * 1024, SSD_SCR = 2 * SSD_BUF;
static_assert(SSD_SCR + 1024 <= 131072, "SSD LDS map");
__device__ __forceinline__ void dma16(const void* g, PG8_LAS unsigned char* l) { __builtin_amdgcn_global_load_lds((const unsigned*)g, (PG8_LAS unsigned*)l, 16, 0, 0); }
__device__ __forceinline__ void dma4(const void* g, PG8_LAS unsigned char* l) { __builtin_amdgcn_global_load_lds((const unsigned*)g, (PG8_LAS unsigned*)l, 4, 0, 0); }
template <bool DRY> __device__ __forceinline__ void ssd_wave(const Params& P, PG8_LAS unsigned char* lds, int unit) {
    const bf16_t* XT = (const bf16_t*)(P.ws + WS_XT); const bf16_t* XC = (const bf16_t*)(P.ws + WS_XC);
    const bf16_t* BC = (const bf16_t*)((const unsigned char*)P.out + DO_BC); const bf16_t* BT = (const bf16_t*)((const unsigned char*)P.out + DO_BT); const float* DTP = (const float*)((const unsigned char*)P.out + DO_DTP);
    bf16_t* GZ = (bf16_t*)(P.ws + WS_GZ); float* SSQ = (float*)(P.ws + WS_SSQ);
    const int lane = threadIdx.x & 63, r32 = lane & 31, hh = lane >> 5;
    const int ph = unit & 1, hd = (unit >> 1) & 15, b = unit >> 5, g = hd >> 3;
    const float a = -__expf(P.a_log[hd]), Dk = P.d_skip[hd];
    PG8_LAS float* ldsw = (PG8_LAS float*)(lds + SSD_SCR);
    f32x16 hT[4];
#pragma unroll
    for (int nbk = 0; nbk < 4; ++nbk)
#pragma unroll
        for (int i = 0; i < 16; ++i) hT[nbk][i] = 0.f;
    const bf16_t* gBC = BC + ((size_t)b * LP + r32) * 512 + g * 128 + 8 * hh;
    const bf16_t* gXT = XT + ((size_t)b * 1024 + hd * 64 + 32 * ph + r32) * LP + 8 * hh;
    const bf16_t* gBT = BT + ((size_t)b * 256 + g * 128 + r32) * LP + 8 * hh;
    const bf16_t* gXC = XC + ((size_t)b * LP + r32) * 1024 + hd * 64 + 32 * ph + 16 * hh;
    const bf16_t* gZ = GZ + ((size_t)b * SEQ + r32) * 2048 + 1024 + hd * 64 + 32 * ph + 4 * hh;
    const float* gDT = DTP + ((size_t)b * LP + lane) * 16 + hd;
#define SSD_ISSUE(c_, buf_) do { const int pp0_ = 64 * (c_); PG8_LAS unsigned char* bb_ = lds + (buf_) * SSD_BUF; \
        _Pragma("unroll") for (int blk = 0; blk < 2; ++blk) _Pragma("unroll") for (int ks = 0; ks < 8; ++ks) { \
            dma16(gBC + (size_t)(pp0_ + 32 * blk) * 512 + 16 * ks, bb_ + (SB_BM + blk * 8 + ks) * 1024); \
            dma16(gBC + (size_t)(pp0_ + 32 * blk) * 512 + 256 + 16 * ks, bb_ + (SB_CM + blk * 8 + ks) * 1024); } \
        _Pragma("unroll") for (int t = 0; t < 4; ++t) dma16(gXT + pp0_ + 16 * t, bb_ + (SB_XT + t) * 1024); \
        _Pragma("unroll") for (int nbk = 0; nbk < 4; ++nbk) _Pragma("unroll") for (int t = 0; t < 4; ++t) dma16(gBT + (size_t)(32 * nbk) * LP + pp0_ + 16 * t, bb_ + (SB_BT + nbk * 4 + t) * 1024); \
        _Pragma("unroll") for (int lb = 0; lb < 2; ++lb) _Pragma("unroll") for (int hf = 0; hf < 2; ++hf) dma16(gXC + (size_t)(pp0_ + 32 * lb) * 1024 + 8 * hf, bb_ + (SB_XC + lb * 2 + hf) * 1024); \
        { const int cz_ = (c_) >= 1 ? (c_) - 1 : 0; \
        _Pragma("unroll") for (int lb = 0; lb < 2; ++lb) _Pragma("unroll") for (int d = 0; d < 8; ++d) dma4(gZ + (size_t)(64 * cz_ + 32 * lb) * 2048 + 8 * (d >> 1) + 2 * (d & 1), bb_ + SB_Z * 1024 + (lb * 8 + d) * 256); } \
        dma4(gDT + (size_t)pp0_ * 16, bb_ + SB_DT * 1024); } while (0)
    SSD_ISSUE(0, 0);
    for (int c = 0; c < 33; ++c) {
        const int pp0 = 64 * c;
        PG8_LAS unsigned char* bb = lds + (c & 1) * SSD_BUF + lane * 16;
        asm volatile("s_waitcnt vmcnt(0) lgkmcnt(0)" ::: "memory");
        if (c + 1 < 33) SSD_ISSUE(c + 1, (c + 1) & 1);
#define SSD_FRAG(slot_) (*(const PG8_LAS bf16x8*)(bb + (slot_) * 1024))
        const float dtl = *(const PG8_LAS float*)(lds + (c & 1) * SSD_BUF + SB_DT * 1024 + lane * 4);
        float ac = dtl * a;
#pragma unroll
        for (int o = 1; o < 64; o <<= 1) { const float t = __shfl_up(ac, o); if (lane >= o) ac += t; }
        const float atot = __shfl(ac, 63);
        ldsw[lane] = ac; ldsw[64 + lane] = dtl; ldsw[128 + lane] = dtl * __expf(atot - ac);
        bf16x8 xtf[4];
#pragma unroll
        for (int t = 0; t < 4; ++t) xtf[t] = SSD_FRAG(SB_XT + t);
#pragma unroll
        for (int lb = 0; lb < 2; ++lb) {
            asm volatile("" ::: "memory");
            f32x16 y, st0, st1;
#pragma unroll
            for (int i = 0; i < 16; ++i) { y[i] = 0.f; st0[i] = 0.f; st1[i] = 0.f; }
#pragma unroll
            for (int ks = 0; ks < 8; ++ks) {
                const bf16x8 cmf = SSD_FRAG(SB_CM + lb * 8 + ks);
                float v[8];
#pragma unroll
                for (int j = 0; j < 8; ++j) v[j] = hT[ks >> 1][8 * (ks & 1) + j];
                y = __builtin_amdgcn_mfma_f32_32x32x16_bf16(pack_bf8(v), cmf, y, 0, 0, 0);
                st0 = __builtin_amdgcn_mfma_f32_32x32x16_bf16(SSD_FRAG(SB_BM + ks), cmf, st0, 0, 0, 0);
                if (lb == 1) st1 = __builtin_amdgcn_mfma_f32_32x32x16_bf16(SSD_FRAG(SB_BM + 8 + ks), cmf, st1, 0, 0, 0);
            }
            const float acl = ldsw[32 * lb + r32], el = __expf(acl);
#pragma unroll
            for (int i = 0; i < 16; ++i) y[i] *= el;
#pragma unroll
            for (int sb = 0; sb <= lb; ++sb) {
                float lt[16];
#pragma unroll
                for (int gq = 0; gq < 4; ++gq) {
                    const f32x4 acs = *(const PG8_LAS f32x4*)(ldsw + 32 * sb + 8 * gq + 4 * hh), dts = *(const PG8_LAS f32x4*)(ldsw + 64 + 32 * sb + 8 * gq + 4 * hh);
#pragma unroll
                    for (int j = 0; j < 4; ++j) { float mm = __expf(acl - acs[j]) * dts[j]; if (sb == lb && (8 * gq + 4 * hh + j) > r32) mm = 0.f; lt[4 * gq + j] = (sb == 0 ? st0[4 * gq + j] : st1[4 * gq + j]) * mm; }
                }
#pragma unroll
                for (int t = 0; t < 2; ++t) y = __builtin_amdgcn_mfma_f32_32x32x16_bf16(xtf[2 * sb + t], pack_bf8(lt + 8 * t), y, 0, 0, 0);
            }
            asm volatile("" ::: "memory");
            if (c >= 1) {
                const size_t m = (size_t)b * SEQ + 64 * (c - 1) + 32 * lb + r32;
                const u32x4 xa = *(const PG8_LAS u32x4*)(bb + (SB_XC + lb * 2) * 1024), xb = *(const PG8_LAS u32x4*)(bb + (SB_XC + lb * 2 + 1) * 1024);
                const unsigned xw[8] = {xa.x, xa.y, xa.z, xa.w, xb.x, xb.y, xb.z, xb.w};
                float ss = 0.f;
#pragma unroll
                for (int gq = 0; gq < 4; ++gq) {
                    const unsigned z0 = *(const PG8_LAS unsigned*)(lds + (c & 1) * SSD_BUF + SB_Z * 1024 + (lb * 8 + 2 * gq) * 256 + lane * 4), z1 = *(const PG8_LAS unsigned*)(lds + (c & 1) * SSD_BUF + SB_Z * 1024 + (lb * 8 + 2 * gq + 1) * 256 + lane * 4);
                    const float y0 = (y[4 * gq] + Dk * bf2f(xw[2 * gq] & 0xffffu)) * bf2f(z0 & 0xffffu), y1 = (y[4 * gq + 1] + Dk * bf2f(xw[2 * gq] >> 16)) * bf2f(z0 >> 16);
                    const float y2 = (y[4 * gq + 2] + Dk * bf2f(xw[2 * gq + 1] & 0xffffu)) * bf2f(z1 & 0xffffu), y3 = (y[4 * gq + 3] + Dk * bf2f(xw[2 * gq + 1] >> 16)) * bf2f(z1 >> 16);
                    ss += (y0 * y0 + y1 * y1) + (y2 * y2 + y3 * y3);
                    if (!DRY) *(u32x2*)(GZ + m * 2048 + 1024 + hd * 64 + 32 * ph + 8 * gq + 4 * hh) = (u32x2){cvtpk(y0, y1), cvtpk(y2, y3)};
                }
                ss += __shfl_xor(ss, 32);
                if (DRY) { if (ss == 12345.678f) SSQ[m * 64 + 16 + 2 * hd + ph] = ss; } else
                if (hh == 0) SSQ[m * 64 + 16 + 2 * hd + ph] = ss;
            }
        }
        asm volatile("" ::: "memory");
        const float dec = __expf(atot);
        bf16x8 xs[4];
#pragma unroll
        for (int t = 0; t < 4; ++t) {
            const f32x4 s0 = *(const PG8_LAS f32x4*)(ldsw + 128 + 16 * t + 4 * hh), s1 = *(const PG8_LAS f32x4*)(ldsw + 128 + 16 * t + 4 * hh + 8);
            float v[8];
#pragma unroll
            for (int j = 0; j < 4; ++j) { v[j] = bf2f((unsigned short)xtf[t][j]) * s0[j]; v[4 + j] = bf2f((unsigned short)xtf[t][4 + j]) * s1[j]; }
            xs[t] = pack_bf8(v);
        }
#pragma unroll
        for (int nbk = 0; nbk < 4; ++nbk) {
            asm volatile("" ::: "memory");
#pragma unroll
            for (int i = 0; i < 16; ++i) hT[nbk][i] *= dec;
#pragma unroll
            for (int t = 0; t < 4; ++t) hT[nbk] = __builtin_amdgcn_mfma_f32_32x32x16_bf16(SSD_FRAG(SB_BT + nbk * 4 + t), xs[t], hT[nbk], 0, 0, 0);
        }
    }
#undef SSD_ISSUE
#undef SSD_FRAG
}

__device__ __forceinline__ void final_norm(const Params& P, int vb, int nb) {
    const int tid = threadIdx.x, lane = tid & 63, wave = tid >> 6;
    for (int m = vb * 8 + wave; m < MX; m += nb * 8) {
        f32x4* xr = (f32x4*)(P.out + (size_t)m * DM) + lane;
        const f32x4* wr = (const f32x4*)P.final_w + lane;
        f32x4 v[4]; float ss = 0.f;
#pragma unroll
        for (int j = 0; j < 4; ++j) { v[j] = xr[64 * j]; ss += (v[j].x * v[j].x + v[j].y * v[j].y) + (v[j].z * v[j].z + v[j].w * v[j].w); }
        const float rstd = 1.0f / sqrtf(wave_sum(ss) * (1.0f / DM) + EPS);
#pragma unroll
        for (int j = 0; j < 4; ++j) { const f32x4 w = wr[64 * j]; xr[64 * j] = (f32x4){v[j].x * rstd * w.x, v[j].y * rstd * w.y, v[j].z * rstd * w.z, v[j].w * rstd * w.w}; }
    }
}

#define XB_TMO      128
#define XB_XCNT(j)  (256  + 64 * (j))
#define XB_XSUB(j)  (1280 + 64 * (j))
#define XB_XGEN(j)  (2304 + 64 * (j))
#define XB_TOP      3328
#define XB_TOPGEN   3392
#define XCD_BAR_WORDS 3456
#define XB_SPIN_CAP (1u << 18)

__device__ __forceinline__ unsigned xb_ld(unsigned* p)              { return __hip_atomic_load(p, __ATOMIC_RELAXED, __HIP_MEMORY_SCOPE_AGENT); }
__device__ __forceinline__ unsigned xb_add(unsigned* p, unsigned v) { return __hip_atomic_fetch_add(p, v, __ATOMIC_RELAXED, __HIP_MEMORY_SCOPE_AGENT); }
__device__ __forceinline__ unsigned xb_xcc_id() { return (unsigned)__builtin_amdgcn_s_getreg((3 << 11) | 20) & 0xFu; }
#define XB_SPIN(cond, bar) do { unsigned _sp = 0; while (cond) { __builtin_amdgcn_s_sleep(1); \
    if ((++_sp & 255u) == 0u) { if (xb_ld(&(bar)[XB_TMO])) break; if (_sp > XB_SPIN_CAP) { atomicAdd(&(bar)[XB_TMO], 1u); break; } } } } while (0)

struct XcdBarrier {
    unsigned* bar; unsigned x;
    volatile PG8_LAS unsigned* st;
};

__device__ __forceinline__ XcdBarrier xcd_barrier_post(unsigned* bar, volatile PG8_LAS unsigned* st) {
    XcdBarrier b; b.bar = bar; b.x = xb_xcc_id(); b.st = st;
    if (threadIdx.x == 0) (void)xb_add(&bar[XB_XCNT(b.x)], 1u);
    return b;
}
__device__ __forceinline__ void xcd_barrier_complete(unsigned* bar, unsigned x, unsigned& nloc, unsigned& nx) {
    const unsigned G = gridDim.x * gridDim.y * gridDim.z;
    unsigned sum, cnt, mine, sp = 0u;
    for (;;) {
        sum = 0u; cnt = 0u; mine = 0u;
#pragma unroll
        for (unsigned j = 0; j < 16; ++j) { const unsigned c = xb_ld(&bar[XB_XCNT(j)]); sum += c; cnt += (c > 0u) ? 1u : 0u; mine = (j == x) ? c : mine; }
        if (sum == G) break;
        __builtin_amdgcn_s_sleep(1);
        if ((++sp & 255u) == 0u) { if (xb_ld(&bar[XB_TMO])) break; if (sp > XB_SPIN_CAP) { atomicAdd(&bar[XB_TMO], 1u); break; } }
    }
    nloc = mine > 0u ? mine : 1u; nx = cnt > 0u ? cnt : 1u;
}

__device__ __forceinline__ void xcd_barrier(const XcdBarrier& b) {
    asm volatile("s_waitcnt vmcnt(0)" ::: "memory");
    __syncthreads();
    if (threadIdx.x == 0) {
        unsigned* bar = b.bar;
        __builtin_amdgcn_s_waitcnt(0);
        unsigned nloc = b.st[0], nx = b.st[1];
        if (nloc == 0u) { xcd_barrier_complete(bar, b.x, nloc, nx); b.st[0] = nloc; b.st[1] = nx; }
        const unsigned old = xb_add(&bar[XB_XSUB(b.x)], 1u);
        const unsigned gen = old / nloc;
        if (old + 1u == (gen + 1u) * nloc) {
            __builtin_amdgcn_fence(__ATOMIC_RELEASE, "agent");
            asm volatile("s_waitcnt vmcnt(0)" ::: "memory");
            const unsigned og = xb_add(&bar[XB_TOP], 1u);
            const unsigned tg = og / nx;
            if (og + 1u == (tg + 1u) * nx) xb_add(&bar[XB_TOPGEN], 1u);
            else XB_SPIN(xb_ld(&bar[XB_TOPGEN]) == tg, bar);
            __builtin_amdgcn_fence(__ATOMIC_ACQUIRE, "agent");
            xb_add(&bar[XB_XGEN(b.x)], 1u);
            asm volatile("s_waitcnt vmcnt(0)" ::: "memory");
        } else {
            XB_SPIN(xb_ld(&bar[XB_XGEN(b.x)]) == gen, bar);
            __builtin_amdgcn_fence(__ATOMIC_ACQUIRE, "agent");
            asm volatile("s_waitcnt vmcnt(0)" ::: "memory");
        }
    }
    __syncthreads();
}

__global__ void __launch_bounds__(NTHREADS, 2) hybrid_fwd(Params P) {
    extern __shared__ __attribute__((aligned(16))) unsigned char lds_raw[];
    float* lds = (float*)lds_raw;
    PG8_LAS unsigned char* ldsl = (PG8_LAS unsigned char*)lds_raw;
    const int vb = blockIdx.x, nb = gridDim.x;
    const int lo = P.ph_lo, hi = P.ph_hi;
    volatile PG8_LAS unsigned* MISC = (volatile PG8_LAS unsigned*)(ldsl + LDS_MISC_OFF);
    if (threadIdx.x < 32) MISC[threadIdx.x] = 0u;
    __syncthreads();
    XcdBarrier bar = xcd_barrier_post((unsigned*)(P.ws + WS_CTL) + CW_BAR, MISC + 8);
#define IN(k) (lo <= (k) && (k) < hi)
#define BOTH(k) (IN(k) && IN((k) + 1))
    if (IN(0)) { phase0(P, vb, nb); if (BOTH(0)) xcd_barrier(bar); }
    if (IN(1)) for (int rep = 0; rep < (PROBE_DUP == 1 ? 2 : 1); ++rep) {
        pg8::Gemm g{(const bf16_t*)(P.ws + WS_XN), (const bf16_t*)(P.ws + WS_WTIN), MA, NPAD, DM};
        Order1 S{nb, vb};
        Epi1M E{(bf16_t*)P.out, (bf16_t*)(P.ws + WS_KB), (bf16_t*)(P.ws + WS_VT), (bf16_t*)(P.ws + WS_GZ), (bf16_t*)(P.ws + WS_XBC), (float*)(P.ws + WS_DT), P.dt_bias};
        pg8::gemm_phase<Epi1M, Order1, true, true>(ldsl, g, S, E);
        if (BOTH(1) || PROBE_DUP == 1) xcd_barrier(bar);
    }
    if (IN(2)) for (int rep = 0; rep < (PROBE_DUP == 2 ? 2 : 1); ++rep) { conv_phase(P, vb, nb); if (BOTH(2) || PROBE_DUP == 2) xcd_barrier(bar); }
    if (IN(3)) {
        const int wave = __builtin_amdgcn_readfirstlane(threadIdx.x >> 6);
#if PROBE_DUP == 31
        if (wave != 0) attn_mfma<true>(P, vb * 7 + (wave - 1), nb * 7);
#elif PROBE_DUP == 32
        if (wave == 0) { for (int u = vb; u < NB * 16 * 2; u += nb) ssd_wave<true>(P, ldsl, u); }
#endif
        if (wave == 0) { for (int u = vb; u < NB * 16 * 2; u += nb) ssd_wave<false>(P, ldsl, u); }
        else attn_mfma<false>(P, vb * 7 + (wave - 1), nb * 7);
        if (BOTH(3)) xcd_barrier(bar);
    }
    if (IN(4)) for (int rep = 0; rep < (PROBE_DUP == 4 ? 2 : 1); ++rep) {
        pg8::Gemm g{(const bf16_t*)(P.ws + WS_GZ), (const bf16_t*)(P.ws + WS_WTOUT), MX, DM, 2048};
        pg8::StaticOrder S; S.init(MX, DM, nb, vb);
        PG8_LAS float* RS = (PG8_LAS float*)(ldsl + pg8::STAGE_BYTES);
        pg8::Unit u0;
        if (S.next(0, u0) && threadIdx.x < 256) { float a, b; row_rstd((const float*)(P.ws + WS_SSQ), u0.pm * 256 + threadIdx.x, a, b); RS[2 * threadIdx.x] = a / b; RS[2 * threadIdx.x + 1] = b; }
        __syncthreads();
        Epi2M E{P.x, P.out, RS};
        pg8::gemm_phase<Epi2M, pg8::StaticOrder, false, true>(ldsl, g, S, E);
        if (BOTH(4) || PROBE_DUP == 4) xcd_barrier(bar);
    }
    if (IN(5)) final_norm(P, vb, nb);
#undef IN
#undef BOTH
}

#ifndef MK_N_LAUNCHES
#define MK_N_LAUNCHES 1
#endif

extern "C" void kernel_launch(void* const* d_in, const int* in_sizes, int n_in, void* d_out, int out_size, void* d_ws, size_t ws_size, hipStream_t stream) {
    static int grid = 0;
    if (grid == 0) {
        if (n_in != 13 || out_size != MX * DM || ws_size < WS_END) { fprintf(stderr, "kernel_launch: unexpected sizes (n_in %d out %d ws %zu)\n", n_in, out_size, ws_size); grid = -1; return; }
        int dev = 0, cus = 0, per_cu = 0;
        (void)hipGetDevice(&dev);
        (void)hipDeviceGetAttribute(&cus, hipDeviceAttributeMultiprocessorCount, dev);
        (void)hipFuncSetAttribute((const void*)hybrid_fwd, hipFuncAttributeMaxDynamicSharedMemorySize, LDS_BYTES);
        (void)hipOccupancyMaxActiveBlocksPerMultiprocessor(&per_cu, (const void*)hybrid_fwd, NTHREADS, LDS_BYTES);
        if (per_cu < 1) { fprintf(stderr, "kernel_launch: occupancy query says %d blocks per CU\n", per_cu); grid = -1; return; }
        grid = cus;
    }
    if (grid < 0) return;
    Params p{};
    p.x = (const float*)d_in[0]; p.meta = (const float*)d_in[1]; p.norm_w = (const float*)d_in[2]; p.w_in = (const float*)d_in[3];
    p.conv_w = (const float*)d_in[4]; p.conv_b = (const float*)d_in[5]; p.dt_bias = (const float*)d_in[6]; p.a_log = (const float*)d_in[7];
    p.d_skip = (const float*)d_in[8]; p.sb_norm_w = (const float*)d_in[9]; p.ssd_norm_w = (const float*)d_in[10]; p.w_out = (const float*)d_in[11];
    p.final_w = (const float*)d_in[12]; p.out = (float*)d_out; p.ws = (unsigned char*)d_ws;
    if (hipMemsetAsync((char*)d_ws + WS_CTL, 0, CTL_ZERO_BYTES, stream) != hipSuccess) { fprintf(stderr, "kernel_launch: hipMemsetAsync of the control words failed\n"); return; }
#if MK_N_LAUNCHES == 1
    p.ph_lo = 0; p.ph_hi = 6;
    hipLaunchKernelGGL(hybrid_fwd, dim3(grid), dim3(NTHREADS), LDS_BYTES, stream, p);
    const hipError_t e = hipPeekAtLastError();
    if (e != hipSuccess) fprintf(stderr, "launch failed: %s (grid %d)\n", hipGetErrorString(e), grid);
#else
    for (int ph = 0; ph < 6; ++ph) { p.ph_lo = ph; p.ph_hi = ph + 1; hipLaunchKernelGGL(hybrid_fwd, dim3(grid), dim3(NTHREADS), LDS_BYTES, stream, p); }
#endif
}
```
